# Optimizing an MI355X kernel written in HIP

```python
import jax, jax.numpy as jnp
from jax import lax
import numpy as np

D_MODEL = 2048
BATCH = 4
SEQ = 2048
DEPTH = 1

MIX_WIDTH = D_MODEL
RET_HEADS = 4
RET_QK_DIM = D_MODEL // 8
RET_V_DIM = D_MODEL // 8
RET_QK_WIDTH = RET_HEADS * RET_QK_DIM
RET_WIDTH = RET_HEADS * RET_V_DIM
ROPE_BASE = 10000.0
SSD_INNER = MIX_WIDTH - RET_WIDTH
SSD_HEAD_DIM = 64
SSD_HEADS = SSD_INNER // SSD_HEAD_DIM
SSD_GROUPS = 2
SSD_STATE = 128
SSD_CONV = 4
SSD_CONV_DIM = SSD_INNER + 2 * SSD_GROUPS * SSD_STATE
CHUNK = 128
IN_WIDTH = 2 * RET_QK_WIDTH + 2 * RET_WIDTH + SSD_INNER + SSD_CONV_DIM + SSD_HEADS
D_FF = 4 * D_MODEL
EPS = 1e-6

kernel_name = "hymba_retention_ssd_hybrid_layer"


def rmsnorm(x, w):
    xf = x.astype(jnp.float32)
    y = xf * lax.rsqrt(jnp.mean(xf * xf, axis=-1, keepdims=True) + EPS)
    return (y * w.astype(jnp.float32)).astype(x.dtype)


def rope(x, pos):
    half = x.shape[-1] // 2
    inv_freq = ROPE_BASE ** (-jnp.arange(half, dtype=jnp.float32) / half)
    ang = pos[:, None] * inv_freq[None, :]
    cos = jnp.cos(ang)[None, :, None, :]
    sin = jnp.sin(ang)[None, :, None, :]
    x1, x2 = x[..., :half], x[..., half:]
    return jnp.concatenate([x1 * cos - x2 * sin, x1 * sin + x2 * cos], axis=-1)


def retention_chunkwise(q, k, v):
    b, s, h, dk = q.shape
    dv = v.shape[-1]
    n = s // CHUNK
    log_gamma = jnp.log(1.0 - 2.0 ** (-5.0 - jnp.arange(h, dtype=jnp.float32)))
    idx = jnp.arange(CHUNK, dtype=jnp.float32)
    rel = idx[:, None] - idx[None, :]
    causal = rel >= 0
    decay_intra = jnp.where(causal[None],
                            jnp.exp(jnp.where(causal, rel, 0.0)[None] * log_gamma[:, None, None]),
                            0.0)
    k = k * (dk ** -0.5)
    qc = q.reshape(b, n, CHUNK, h, dk)
    kc = k.reshape(b, n, CHUNK, h, dk)
    vc = v.reshape(b, n, CHUNK, h, dv)
    scores = jnp.einsum('bnchd,bnmhd->bnhcm', qc, kc) * decay_intra
    y_intra = jnp.einsum('bnhcm,bnmhe->bnche', scores, vc)
    k_decay = jnp.exp((CHUNK - 1.0 - idx)[None, :] * log_gamma[:, None])
    kv = jnp.einsum('bnmhd,bnmhe,hm->nbhde', kc, vc, k_decay)
    chunk_decay = jnp.exp(CHUNK * log_gamma)[None, :, None, None]

    def step(state, kv_n):
        return chunk_decay * state + kv_n, state

    _, prev = lax.scan(step, jnp.zeros((b, h, dk, dv), kv.dtype), kv)
    q_decay = jnp.exp((idx + 1.0)[None, :] * log_gamma[:, None])
    y_cross = jnp.einsum('bnchd,nbhde,hc->bnche', qc, prev, q_decay)
    return (y_intra + y_cross).reshape(b, s, h, dv)


def ssd_chunked(x, dt, a, bmat, cmat):
    b, s, H, p = x.shape
    G, N = bmat.shape[2], bmat.shape[3]
    E = H // G
    n = s // CHUNK
    xc = (x * dt[..., None]).reshape(b, n, CHUNK, G, E, p)
    ac = (dt * a).reshape(b, n, CHUNK, G, E)
    bc = bmat.reshape(b, n, CHUNK, G, N)
    cc = cmat.reshape(b, n, CHUNK, G, N)
    a_cs = jnp.cumsum(ac, axis=2)
    seg = a_cs[:, :, :, None] - a_cs[:, :, None, :]
    causal = (jnp.arange(CHUNK)[:, None] >= jnp.arange(CHUNK)[None, :])[:, :, None, None]
    L = jnp.exp(jnp.where(causal, seg, -jnp.inf))
    cb = jnp.einsum('bnlgk,bnsgk->bnlsg', cc, bc)
    y_diag = jnp.einsum('bnlsg,bnlsge,bnsgep->bnlgep', cb, L, xc)
    decay_states = jnp.exp(a_cs[:, :, -1:] - a_cs)
    states = jnp.einsum('bnlgk,bnlge,bnlgep->nbgepk', bc, decay_states, xc)
    chunk_decay = jnp.moveaxis(jnp.exp(a_cs[:, :, -1]), 1, 0)

    def step(state, inp):
        st, dec = inp
        return dec[..., None, None] * state + st, state

    _, prev = lax.scan(step, jnp.zeros((b, G, E, p, N), states.dtype), (states, chunk_decay))
    y_off = jnp.einsum('bnlgk,nbgepk,bnlge->bnlgep', cc, prev, jnp.exp(a_cs))
    return (y_diag + y_off).reshape(b, s, H, p)


def causal_depthwise_conv(u, w, bias):
    K, c = w.shape
    out = lax.conv_general_dilated(u, w[:, None, :], window_strides=(1,), padding=[(K - 1, 0)],
                                   dimension_numbers=('NWC', 'WIO', 'NWC'), feature_group_count=c)
    return out + bias


def hybrid_mixer(h, w_in, ret_norm_w, conv_w, conv_b, dt_bias, a_log, d_skip, ssd_norm_w, w_out):
    b, s, _ = h.shape
    f32 = jnp.float32
    proj = jnp.einsum('bsd,df->bsf', h, w_in)
    o1 = RET_QK_WIDTH
    o2 = o1 + RET_QK_WIDTH
    o3 = o2 + RET_WIDTH
    o4 = o3 + RET_WIDTH
    o5 = o4 + SSD_INNER
    o6 = o5 + SSD_CONV_DIM
    q, k, v, g, z, xbc, dt = jnp.split(proj, [o1, o2, o3, o4, o5, o6], axis=-1)

    pos = jnp.arange(s, dtype=f32)
    q = rope(q.astype(f32).reshape(b, s, RET_HEADS, RET_QK_DIM), pos)
    k = rope(k.astype(f32).reshape(b, s, RET_HEADS, RET_QK_DIM), pos)
    v = v.astype(f32).reshape(b, s, RET_HEADS, RET_V_DIM)
    y_ret = retention_chunkwise(q, k, v)
    y_ret = y_ret * lax.rsqrt(jnp.mean(y_ret * y_ret, axis=-1, keepdims=True) + EPS)
    y_ret = y_ret * ret_norm_w.astype(f32).reshape(RET_HEADS, RET_V_DIM)
    y_ret = y_ret.reshape(b, s, RET_WIDTH) * jax.nn.silu(g.astype(f32))

    xbc = jax.nn.silu(causal_depthwise_conv(xbc.astype(f32), conv_w.astype(f32), conv_b.astype(f32)))
    xs, bm, cm = jnp.split(xbc, [SSD_INNER, SSD_INNER + SSD_GROUPS * SSD_STATE], axis=-1)
    xs = xs.reshape(b, s, SSD_HEADS, SSD_HEAD_DIM)
    bm = bm.reshape(b, s, SSD_GROUPS, SSD_STATE)
    cm = cm.reshape(b, s, SSD_GROUPS, SSD_STATE)
    dt = jax.nn.softplus(dt.astype(f32) + dt_bias.astype(f32))
    a = -jnp.exp(a_log.astype(f32))
    y_ssd = ssd_chunked(xs, dt, a, bm, cm) + d_skip.astype(f32)[:, None] * xs
    y_ssd = y_ssd.reshape(b, s, SSD_INNER) * jax.nn.silu(z.astype(f32))
    y_ssd = y_ssd.reshape(b, s, SSD_GROUPS, SSD_INNER // SSD_GROUPS)
    y_ssd = y_ssd * lax.rsqrt(jnp.mean(y_ssd * y_ssd, axis=-1, keepdims=True) + EPS)
    y_ssd = y_ssd.reshape(b, s, SSD_INNER) * ssd_norm_w.astype(f32)

    mix = jnp.concatenate([y_ret, y_ssd], axis=-1).astype(h.dtype)
    return jnp.einsum('bsf,fd->bsd', mix, w_out)


def squared_relu_mlp(h, w_up, w_down):
    u = jax.nn.relu(jnp.einsum('bsd,df->bsf', h, w_up))
    return jnp.einsum('bsf,fd->bsd', u * u, w_down)


def setup_inputs(seed: int = 0) -> dict:
    key = jax.random.key(seed)
    ks = jax.random.split(key, 16)
    f32 = jnp.float32
    x = jax.random.normal(ks[0], (BATCH, SEQ, D_MODEL), f32)
    norm_mix_w = 1.0 + 0.01 * jax.random.normal(ks[1], (D_MODEL,), f32)
    w_in = jax.random.normal(ks[2], (D_MODEL, IN_WIDTH), f32) * D_MODEL ** -0.5
    ret_norm_w = 1.0 + 0.01 * jax.random.normal(ks[3], (RET_WIDTH,), f32)
    conv_w = jax.random.normal(ks[4], (SSD_CONV, SSD_CONV_DIM), f32) * SSD_CONV ** -0.5
    conv_b = 0.01 * jax.random.normal(ks[5], (SSD_CONV_DIM,), f32)
    dt0 = jnp.exp(jax.random.uniform(ks[6], (SSD_HEADS,), f32, jnp.log(1e-3), jnp.log(1e-1)))
    dt_bias = dt0 + jnp.log(-jnp.expm1(-dt0))
    a_log = jnp.log(jax.random.uniform(ks[7], (SSD_HEADS,), f32, 1.0, 16.0))
    d_skip = 1.0 + 0.01 * jax.random.normal(ks[8], (SSD_HEADS,), f32)
    ssd_norm_w = 1.0 + 0.01 * jax.random.normal(ks[9], (SSD_INNER,), f32)
    w_out = jax.random.normal(ks[10], (MIX_WIDTH, D_MODEL), f32) * MIX_WIDTH ** -0.5
    norm_mlp_w = 1.0 + 0.01 * jax.random.normal(ks[11], (D_MODEL,), f32)
    w_up = jax.random.normal(ks[12], (D_MODEL, D_FF), f32) * D_MODEL ** -0.5
    w_down = jax.random.normal(ks[13], (D_FF, D_MODEL), f32) * D_FF ** -0.5
    norm_final_w = 1.0 + 0.01 * jax.random.normal(ks[14], (D_MODEL,), f32)
    return {"x": x, "norm_mix_w": norm_mix_w, "w_in": w_in, "ret_norm_w": ret_norm_w,
            "conv_w": conv_w, "conv_b": conv_b, "dt_bias": dt_bias, "a_log": a_log,
            "d_skip": d_skip, "ssd_norm_w": ssd_norm_w, "w_out": w_out,
            "norm_mlp_w": norm_mlp_w, "w_up": w_up, "w_down": w_down,
            "norm_final_w": norm_final_w}


def reference(x, norm_mix_w, w_in, ret_norm_w, conv_w, conv_b, dt_bias, a_log, d_skip,
              ssd_norm_w, w_out, norm_mlp_w, w_up, w_down, norm_final_w):
    h = x
    for _ in range(DEPTH):
        h = h + hybrid_mixer(rmsnorm(h, norm_mix_w), w_in, ret_norm_w, conv_w, conv_b,
                             dt_bias, a_log, d_skip, ssd_norm_w, w_out)
        h = h + squared_relu_mlp(rmsnorm(h, norm_mlp_w), w_up, w_down)
    return rmsnorm(h, norm_final_w)
```

```cpp
#include <hip/hip_runtime.h>
#include <hip/hip_cooperative_groups.h>
#include <cstdio>
#include <cstdint>
namespace cg = cooperative_groups;
namespace pg8 {
#define PG8_LAS __attribute__((address_space(3)))
typedef unsigned short bf16_t;
typedef short bf16x8 __attribute__((ext_vector_type(8)));
typedef float f32x4 __attribute__((ext_vector_type(4)));
typedef unsigned u32x4 __attribute__((ext_vector_type(4)));
constexpr int BM = 256, BK = 64, HALF = 128, HTB = HALF * BK * 2  , STAGE_BYTES = 8 * HTB, NXCD = 8, WGM = 8;

__host__ __device__ __forceinline__ int lds_byte(int r, int c) { const int st = (r >> 4) * 2 + (c >> 5), rr = r & 15, cc = c & 31, ob = rr * 64 + cc * 2; return st * 1024 + (ob ^ (((ob >> 9) & 1) << 5)); }
__host__ __device__ __forceinline__ void stage_rc(int b, int& R, int& C) { const int st = b / 1024, sb = b % 1024, swz = sb ^ (((sb >> 9) & 1) << 5); R = (st >> 1) * 16 + swz / 64; C = (st & 1) * 32 + (swz % 64) / 2; }
__host__ __device__ __forceinline__ int perm32(int rho) { const int n = rho >> 4, i = rho & 15; return 8 * (i >> 2) + 4 * n + (i & 3); }

struct Unit { int pm, pn; };
struct Gemm { const bf16_t* A; const bf16_t* Bt; int M, N, K; };

struct StaticOrder {
    int nM, nN, nwg, G, c;
    __host__ __device__ void init(int M, int N, int G_, int c_) { nM = M / BM; nN = N / BM; nwg = nM * nN; G = G_; c = c_; }
    __host__ __device__ bool next(int i, Unit& u) const {
        const long L = (long)i * G + c; if (L >= nwg) return false;
        int wgid = (int)L; { const int q = nwg / NXCD, r = nwg % NXCD, xcd = wgid % NXCD, off = wgid / NXCD; wgid = (xcd < r ? xcd * (q + 1) : r * (q + 1) + (xcd - r) * q) + off; }
        const int nig = WGM * nN, gid = wgid / nig, fm = gid * WGM, gsz = (nM - fm) < WGM ? (nM - fm) : WGM;
        u.pm = fm + ((wgid % nig) % gsz); u.pn = (wgid % nig) / gsz; return true;
    }
    __device__ __forceinline__ void a_ready(const Unit&) const {}
    __device__ __forceinline__ void done(const Unit&) const {}
};
typedef float f32x2_cv __attribute__((ext_vector_type(2))); typedef __bf16 bf16x2_cv __attribute__((ext_vector_type(2)));
__device__ __forceinline__ unsigned cvt_pk_bf16(float lo, float hi) { const f32x2_cv v = {lo, hi}; const bf16x2_cv b = __builtin_convertvector(v, bf16x2_cv); return __builtin_bit_cast(unsigned, b); }
typedef float f32x2 __attribute__((ext_vector_type(2)));
template <class Epi, class Sched, bool ALIGN_EPI = false, bool SP2 = false>
__device__ __forceinline__ void gemm_phase(PG8_LAS unsigned char* lds, const Gemm g, const Sched& S, const Epi& E) {
    int tid_l = threadIdx.x; asm volatile("" : "+v"(tid_l));
    const int tid = tid_l, wid = __builtin_amdgcn_readfirstlane(tid >> 6), lane = tid & 63, wr = wid >> 2, wc = wid & 3, fr = lane & 15, fq = lane >> 4;
    const int K = g.K, nt = K / BK;
    unsigned voffA[2], voffB[2];
#pragma unroll
    for (int i = 0; i < 2; ++i) { int R, C; stage_rc(tid * 16 + i * 8192, R, C); const int Rb = Epi::PERM ? ((R & ~31) + perm32(R & 31)) : R;
        voffA[i] = (unsigned)(R * K + C) * 2u; voffB[i] = (unsigned)(Rb * K + C) * 2u; }
    const size_t kstep = (size_t)(BK * 2);
    const size_t hstep = (size_t)HALF * K * 2;
    const size_t tstep = 2 * hstep;
    const unsigned ldsw = (unsigned)wid * 1024u;
    const int aoff = lds_byte(wr * 64 + fr, fq * 8), boff = lds_byte(wc * 32 + fr, fq * 8);
#define PG8_SA(b, h) (((b) * 2 + (h)) * HTB)
#define PG8_SB(b, h) ((4 + (b) * 2 + (h)) * HTB)
#define PG8_STAGE(bufoff, gbase, voff) do { _Pragma("unroll") for (int _i = 0; _i < 2; ++_i) \
        __builtin_amdgcn_global_load_lds((const unsigned*)((const char*)(gbase) + (voff)[_i]), (PG8_LAS unsigned*)(lds + (bufoff) + ldsw + _i * 8192), 16, 0, 0); } while (0)
#define PG8_LDA(dst, b, h) do { _Pragma("unroll") for (int m = 0; m < 4; ++m) _Pragma("unroll") for (int k = 0; k < 2; ++k) dst[m][k] = *(const PG8_LAS bf16x8*)(lds + PG8_SA(b, h) + aoff + m * 2048 + k * 1024); } while (0)
#define PG8_LDB(dst, b, h) do { _Pragma("unroll") for (int n = 0; n < 2; ++n) _Pragma("unroll") for (int k = 0; k < 2; ++k) dst[n][k] = *(const PG8_LAS bf16x8*)(lds + PG8_SB(b, h) + boff + n * 2048 + k * 1024); } while (0)
#define PG8_MMA(ai, bj, At, Bt) do { __builtin_amdgcn_s_setprio(1); _Pragma("unroll") for (int m = 0; m < 4; ++m) _Pragma("unroll") for (int n = 0; n < 2; ++n) _Pragma("unroll") for (int k = 0; k < 2; ++k) \
        acc[ai][bj][m][n] = __builtin_amdgcn_mfma_f32_16x16x32_bf16(Bt[n][k], At[m][k], acc[ai][bj][m][n], 0, 0, 0); __builtin_amdgcn_s_setprio(0); } while (0)
#define PG8_WAIT_V(n) asm volatile("s_waitcnt vmcnt(" #n ")" ::: "memory")
#define PG8_WAIT_L(n) asm volatile("s_waitcnt lgkmcnt(" #n ")" ::: "memory")
#define PG8_BAR __builtin_amdgcn_s_barrier()
#define PG8_SCHED __builtin_amdgcn_sched_barrier(0)
    Unit cur, nxt; int ui = 0;
    if (!S.next(0, cur)) return;
    f32x4 acc[2][2][4][2];
#pragma unroll
    for (int a = 0; a < 2; ++a)
#pragma unroll
        for (int b = 0; b < 2; ++b)
#pragma unroll
            for (int m = 0; m < 4; ++m)
#pragma unroll
                for (int n = 0; n < 2; ++n) acc[a][b][m][n] = (f32x4){0.f, 0.f, 0.f, 0.f};
    bf16x8 At[4][2], B0[2][2], B1[2][2];
    const char* cA = (const char*)g.A + (size_t)cur.pm * tstep; const char* cB = (const char*)g.Bt + (size_t)cur.pn * tstep;
    S.a_ready(cur);
    if constexpr (SP2) {
        PG8_STAGE(PG8_SB(0, 0), cB, voffB); PG8_STAGE(PG8_SB(0, 1), cB + hstep, voffB); PG8_STAGE(PG8_SA(0, 0), cA, voffA); PG8_STAGE(PG8_SA(0, 1), cA + hstep, voffA);
        if (wr == 1) PG8_BAR;
        PG8_WAIT_V(2); PG8_BAR;
        PG8_STAGE(PG8_SB(1, 0), cB + kstep, voffB); PG8_STAGE(PG8_SA(1, 0), cA + kstep, voffA); PG8_STAGE(PG8_SB(1, 1), cB + hstep + kstep, voffB);
        PG8_WAIT_V(6); PG8_BAR;
    } else {
        PG8_STAGE(PG8_SB(0, 0), cB, voffB); PG8_STAGE(PG8_SA(0, 0), cA, voffA); PG8_STAGE(PG8_SB(0, 1), cB + hstep, voffB); PG8_STAGE(PG8_SA(0, 1), cA + hstep, voffA);
        if (wr == 1) PG8_BAR;
        PG8_WAIT_V(4); PG8_BAR;
        PG8_STAGE(PG8_SB(1, 0), cB + kstep, voffB); PG8_STAGE(PG8_SA(1, 0), cA + kstep, voffA); PG8_STAGE(PG8_SB(1, 1), cB + hstep + kstep, voffB);
        PG8_WAIT_V(6); PG8_BAR;
    }
    for (;;) {
        const bool has_next = S.next(ui + 1, nxt);
        const char* nA = has_next ? (const char*)g.A + (size_t)nxt.pm * tstep : cA; const char* nB = has_next ? (const char*)g.Bt + (size_t)nxt.pn * tstep : cB;
        for (int t = 0; t < nt; t += 2) {
            const bool last = (t == nt - 2);
            const char* a1 = cA + (size_t)(t + 1) * kstep;
            const char* a2 = last ? nA : cA + (size_t)(t + 2) * kstep; const char* b2 = last ? nB : cB + (size_t)(t + 2) * kstep;
            const char* a3 = a2 + kstep; const char* b3 = b2 + kstep;
            if (last && has_next) S.a_ready(nxt);
            if constexpr (SP2) {
            PG8_LDB(B0, 0, 0); PG8_LDB(B1, 0, 1); PG8_SCHED; PG8_LDA(At, 0, 0); PG8_STAGE(PG8_SA(1, 1), a1 + hstep, voffA);
            PG8_WAIT_V(8); PG8_WAIT_L(0); PG8_BAR; PG8_MMA(0, 0, At, B0); PG8_MMA(0, 1, At, B1); PG8_BAR; PG8_SCHED;
            PG8_LDA(At, 0, 1); PG8_STAGE(PG8_SB(0, 0), b2, voffB); PG8_STAGE(PG8_SB(0, 1), b2 + hstep, voffB); PG8_STAGE(PG8_SA(0, 0), a2, voffA);
            PG8_WAIT_V(8); PG8_WAIT_L(0); PG8_BAR; PG8_MMA(1, 0, At, B0); PG8_MMA(1, 1, At, B1); PG8_BAR; PG8_SCHED;
            PG8_LDB(B0, 1, 0); PG8_LDB(B1, 1, 1); PG8_SCHED; PG8_LDA(At, 1, 0); PG8_STAGE(PG8_SA(0, 1), a2 + hstep, voffA);
            PG8_WAIT_V(8); PG8_WAIT_L(0); PG8_BAR; PG8_MMA(0, 0, At, B0); PG8_MMA(0, 1, At, B1); PG8_BAR; PG8_SCHED;
            PG8_LDA(At, 1, 1); PG8_STAGE(PG8_SB(1, 0), b3, voffB); PG8_STAGE(PG8_SB(1, 1), b3 + hstep, voffB); PG8_STAGE(PG8_SA(1, 0), a3, voffA);
            PG8_WAIT_V(8); PG8_WAIT_L(0); PG8_BAR; PG8_MMA(1, 0, At, B0); PG8_MMA(1, 1, At, B1); PG8_BAR; PG8_SCHED;
            } else {
            PG8_LDB(B0, 0, 0); PG8_SCHED; PG8_LDA(At, 0, 0); PG8_STAGE(PG8_SA(1, 1), a1 + hstep, voffA);
            PG8_WAIT_L(8); PG8_BAR; PG8_WAIT_L(0); PG8_MMA(0, 0, At, B0); PG8_BAR; PG8_SCHED;
            PG8_LDB(B1, 0, 1); PG8_STAGE(PG8_SB(0, 0), b2, voffB);
            PG8_BAR; PG8_WAIT_L(0); PG8_MMA(0, 1, At, B1); PG8_BAR;
            PG8_LDA(At, 0, 1); PG8_STAGE(PG8_SA(0, 0), a2, voffA);
            PG8_BAR; PG8_WAIT_L(0); PG8_MMA(1, 0, At, B0); PG8_BAR; PG8_SCHED;
            PG8_STAGE(PG8_SB(0, 1), b2 + hstep, voffB);
            PG8_WAIT_V(6); PG8_BAR; PG8_MMA(1, 1, At, B1); PG8_BAR;
            PG8_LDB(B0, 1, 0); PG8_SCHED; PG8_LDA(At, 1, 0); PG8_STAGE(PG8_SA(0, 1), a2 + hstep, voffA);
            PG8_WAIT_L(8); PG8_BAR; PG8_WAIT_L(0); PG8_MMA(0, 0, At, B0); PG8_BAR; PG8_SCHED;
            PG8_LDB(B1, 1, 1); PG8_STAGE(PG8_SB(1, 0), b3, voffB);
            PG8_BAR; PG8_WAIT_L(0); PG8_MMA(0, 1, At, B1); PG8_BAR;
            PG8_LDA(At, 1, 1); PG8_STAGE(PG8_SA(1, 0), a3, voffA);
            PG8_BAR; PG8_WAIT_L(0); PG8_MMA(1, 0, At, B0); PG8_BAR; PG8_SCHED;
            PG8_STAGE(PG8_SB(1, 1), b3 + hstep, voffB);
            PG8_WAIT_V(6); PG8_BAR; PG8_MMA(1, 1, At, B1); PG8_BAR;
            }
        }
        if constexpr (ALIGN_EPI) { if (wr == 0) PG8_BAR; }
        if constexpr (!Epi::AFTER_DRAIN) { E(acc, cur, wr, wc, fr, fq); S.done(cur); }
        if (!has_next) break;
#pragma unroll
        for (int a = 0; a < 2; ++a)
#pragma unroll
            for (int b = 0; b < 2; ++b)
#pragma unroll
                for (int m = 0; m < 4; ++m)
#pragma unroll
                    for (int n = 0; n < 2; ++n) acc[a][b][m][n] = (f32x4){0.f, 0.f, 0.f, 0.f};
        cur = nxt; cA = nA; cB = nB; ++ui;
        if constexpr (ALIGN_EPI) { if (wr == 1) PG8_BAR; }
    }
    PG8_WAIT_V(0);
    if constexpr (!ALIGN_EPI) { if (wr == 0) PG8_BAR; }
    PG8_BAR;
    if constexpr (Epi::AFTER_DRAIN) { E.fused(acc, cur, wr, wc, fr, fq, lds, wid, lane); S.done(cur); }
#undef PG8_SA
#undef PG8_SB
#undef PG8_STAGE
#undef PG8_LDA
#undef PG8_LDB
#undef PG8_MMA
#undef PG8_WAIT_V
#undef PG8_WAIT_L
#undef PG8_BAR
#undef PG8_SCHED
}
}

using pg8::bf16_t; using pg8::bf16x8; using pg8::f32x4; using pg8::u32x4; using pg8::Unit; using pg8::cvt_pk_bf16;
#define LAS __attribute__((address_space(3)))
typedef short s16x4 __attribute__((ext_vector_type(4)));

constexpr int NT = 8192;
constexpr int SEQ = 2048, DM = 2048, DFF = 8192, INW = 6672, INW_PAD = 6912;
constexpr int CONVD = 1536;
constexpr float EPS = 1e-6f;
constexpr size_t MiB = 1u << 20;
constexpr size_t WS_HBUF = 0;
constexpr size_t WS_Q = 32 * MiB, WS_K = 48 * MiB, WS_V = 64 * MiB, WS_G = 80 * MiB, WS_Z = 96 * MiB;
constexpr size_t WS_SS = 112 * MiB;
constexpr size_t WS_U = 0;
constexpr size_t WS_WIN = 128 * MiB;
constexpr size_t WS_WUP = 128 * MiB;
constexpr size_t WS_SR = 160 * MiB;
constexpr size_t WS_WDN = 160 * MiB;
constexpr size_t WS_XBC = 192 * MiB;
constexpr size_t WS_DT = 216 * MiB;
constexpr size_t WS_ACS = 217 * MiB;
constexpr size_t WS_H2W = 192 * MiB;
constexpr size_t WS_XC = 224 * MiB;
constexpr size_t WS_SSQ2 = 224 * MiB;
constexpr size_t WS_SSQ3 = 225 * MiB;
constexpr size_t WS_WOUT = 248 * MiB;
constexpr int LDS_BYTES = 139264;

struct Args {
    const float* x; const float* norm_mix_w; const float* w_in; const float* ret_norm_w; const float* conv_w; const float* conv_b;
    const float* dt_bias; const float* a_log; const float* d_skip; const float* ssd_norm_w; const float* w_out; const float* norm_mlp_w;
    const float* w_up; const float* w_down; const float* norm_final_w;
    float* out; unsigned char* ws;
};

__device__ __forceinline__ float bf2f(unsigned short b) { return __builtin_bit_cast(float, (unsigned)b << 16); }
__device__ __forceinline__ float bflo(unsigned w) { return __builtin_bit_cast(float, w << 16); }
__device__ __forceinline__ float bfhi(unsigned w) { return __builtin_bit_cast(float, w & 0xffff0000u); }
__device__ __forceinline__ unsigned short f2bf(float f) { return (unsigned short)(cvt_pk_bf16(f, 0.f) & 0xffffu); }
__device__ __forceinline__ float silu_f(float x) { return x / (1.f + __expf(-x)); }
__device__ __forceinline__ float wave_sum(float v) {
#pragma unroll
    for (int o = 1; o < 64; o <<= 1) v += __shfl_xor(v, o);
    return v;
}
__device__ __forceinline__ f32x4 mfma16(bf16x8 a, bf16x8 b, f32x4 c) { return __builtin_amdgcn_mfma_f32_16x16x32_bf16(a, b, c, 0, 0, 0); }
__device__ __forceinline__ bf16x8 frag_row(const LAS unsigned char* base, int pitchB, int r0, int c0, int lane) {
    return *(const LAS bf16x8*)(base + (r0 + (lane & 15)) * pitchB + (c0 + 8 * (lane >> 4)) * 2);
}
__device__ __forceinline__ bf16x8 frag_tr(const LAS unsigned char* base, int pitchB, int k0, int c0, int lane) {
    const int g = lane >> 4, q = (lane & 15) >> 2, p = lane & 3;
    const LAS unsigned char* a = base + (k0 + 8 * g + q) * pitchB + (c0 + 4 * p) * 2;
    const s16x4 lo = __builtin_amdgcn_ds_read_tr16_b64_v4i16((LAS s16x4*)a);
    const s16x4 hi = __builtin_amdgcn_ds_read_tr16_b64_v4i16((LAS s16x4*)(a + 4 * pitchB));
    bf16x8 r; r[0] = lo[0]; r[1] = lo[1]; r[2] = lo[2]; r[3] = lo[3]; r[4] = hi[0]; r[5] = hi[1]; r[6] = hi[2]; r[7] = hi[3];
    return r;
}
__device__ __forceinline__ bf16x8 gfrag_row(const bf16_t* base, int ld, int r0, int c0, int lane) {
    return *(const bf16x8*)(base + (size_t)(r0 + (lane & 15)) * ld + c0 + 8 * (lane >> 4));
}
#define WAVE_LDS_SYNC() asm volatile("s_waitcnt lgkmcnt(0)" ::: "memory")

struct EpiInProj {
    static constexpr bool PERM = true, AFTER_DRAIN = false;
    bf16_t *qkvgz, *xbc; float* dt; const float* dt_bias;
    __device__ __forceinline__ void operator()(const f32x4 (&acc)[2][2][4][2], const Unit& u, int wr, int wc, int fr, int fq) const {
        const int row0 = u.pm * 256 + wr * 64 + fr, pn = u.pn, cw = wc * 32 + 8 * fq;
        if (pn < 8) {
            bf16_t* base = qkvgz + (size_t)(pn >> 2) * (size_t)(NT * 1024); const float sc = (pn < 4) ? 1.f : 0.0625f; const int hc = (pn & 3) * 256;
            float invf[2][4];
#pragma unroll
            for (int n = 0; n < 2; ++n)
#pragma unroll
                for (int j = 0; j < 4; ++j) invf[n][j] = exp2f(-(float)(cw + 4 * n + j) * (13.287712379549449f / 128.f)) * 0.15915494309189535f;
#pragma unroll
            for (int ai = 0; ai < 2; ++ai)
#pragma unroll
                for (int m = 0; m < 4; ++m) {
                    const int row = row0 + ai * 128 + m * 16; const float pos = (float)(row & (SEQ - 1));
                    float o1[8], o2[8];
#pragma unroll
                    for (int n = 0; n < 2; ++n)
#pragma unroll
                        for (int j = 0; j < 4; ++j) {
                            float rev = pos * invf[n][j]; rev -= floorf(rev);
                            const float s = __builtin_amdgcn_sinf(rev), c = __builtin_amdgcn_cosf(rev);
                            const float x1 = acc[ai][0][m][n][j], x2 = acc[ai][1][m][n][j];
                            o1[n * 4 + j] = (x1 * c - x2 * s) * sc; o2[n * 4 + j] = (x1 * s + x2 * c) * sc;
                        }
                    u32x4 w1, w2;
                    w1.x = cvt_pk_bf16(o1[0], o1[1]); w1.y = cvt_pk_bf16(o1[2], o1[3]); w1.z = cvt_pk_bf16(o1[4], o1[5]); w1.w = cvt_pk_bf16(o1[6], o1[7]);
                    w2.x = cvt_pk_bf16(o2[0], o2[1]); w2.y = cvt_pk_bf16(o2[2], o2[3]); w2.z = cvt_pk_bf16(o2[4], o2[5]); w2.w = cvt_pk_bf16(o2[6], o2[7]);
                    bf16_t* rp = base + (size_t)row * 1024 + hc + cw;
                    *(u32x4*)rp = w1; *(u32x4*)(rp + 128) = w2;
                }
        } else if (pn < 26) {
            bf16_t* base; int ld, hc; bool act;
            if (pn < 20) { base = qkvgz + (size_t)(pn >> 2) * (size_t)(NT * 1024); act = (pn >= 12); ld = 1024; hc = (pn & 3) * 256; }
            else { base = xbc; act = false; ld = CONVD; hc = (pn - 20) * 256; }
#pragma unroll
            for (int ai = 0; ai < 2; ++ai)
#pragma unroll
                for (int m = 0; m < 4; ++m) {
                    bf16_t* rp = base + (size_t)(row0 + ai * 128 + m * 16) * ld + hc + cw;
#pragma unroll
                    for (int bj = 0; bj < 2; ++bj) {
                        f32x4 v0 = acc[ai][bj][m][0], v1 = acc[ai][bj][m][1];
                        if (act) {
#pragma unroll
                            for (int j = 0; j < 4; ++j) { v0[j] = silu_f(v0[j]); v1[j] = silu_f(v1[j]); }
                        }
                        u32x4 w; w.x = cvt_pk_bf16(v0[0], v0[1]); w.y = cvt_pk_bf16(v0[2], v0[3]); w.z = cvt_pk_bf16(v1[0], v1[1]); w.w = cvt_pk_bf16(v1[2], v1[3]);
                        *(u32x4*)(rp + bj * 128) = w;
                    }
                }
        } else {
            if (wc == 0 && fq < 2) {
#pragma unroll
                for (int ai = 0; ai < 2; ++ai)
#pragma unroll
                    for (int m = 0; m < 4; ++m) {
                        const int row = row0 + ai * 128 + m * 16;
#pragma unroll
                        for (int n = 0; n < 2; ++n) {
                            f32x4 o;
#pragma unroll
                            for (int j = 0; j < 4; ++j) { const float xv = acc[ai][0][m][n][j] + dt_bias[8 * fq + 4 * n + j]; o[j] = (xv > 20.f) ? xv : log1pf(__expf(xv)); }
                            *(f32x4*)(dt + (size_t)row * 16 + 8 * fq + 4 * n) = o;
                        }
                    }
            }
        }
    }
};
struct EpiOutProj {
    static constexpr bool PERM = true, AFTER_DRAIN = false;
    const float* x; float* h2; bf16_t* h2w; const float* nw; float* ssq;
    __device__ __forceinline__ void operator()(const f32x4 (&acc)[2][2][4][2], const Unit& u, int wr, int wc, int fr, int fq) const {
        const int row0 = u.pm * 256 + wr * 64 + fr, c0 = u.pn * 256 + wc * 32 + 8 * fq;
#pragma unroll
        for (int ai = 0; ai < 2; ++ai)
#pragma unroll
            for (int m = 0; m < 4; ++m) {
                const int row = row0 + ai * 128 + m * 16; float ss = 0.f;
#pragma unroll
                for (int bj = 0; bj < 2; ++bj) {
                    const size_t off = (size_t)row * DM + c0 + bj * 128;
                    const f32x4 x0 = *(const f32x4*)(x + off), x1 = *(const f32x4*)(x + off + 4);
                    const f32x4 v0 = acc[ai][bj][m][0] + x0, v1 = acc[ai][bj][m][1] + x1;
                    *(f32x4*)(h2 + off) = v0; *(f32x4*)(h2 + off + 4) = v1;
                    ss += (v0[0] * v0[0] + v0[1] * v0[1]) + (v0[2] * v0[2] + v0[3] * v0[3]) + (v1[0] * v1[0] + v1[1] * v1[1]) + (v1[2] * v1[2] + v1[3] * v1[3]);
                    const f32x4 w0 = *(const f32x4*)(nw + c0 + bj * 128), w1 = *(const f32x4*)(nw + c0 + bj * 128 + 4);
                    u32x4 w; w.x = cvt_pk_bf16(v0[0] * w0[0], v0[1] * w0[1]); w.y = cvt_pk_bf16(v0[2] * w0[2], v0[3] * w0[3]);
                    w.z = cvt_pk_bf16(v1[0] * w1[0], v1[1] * w1[1]); w.w = cvt_pk_bf16(v1[2] * w1[2], v1[3] * w1[3]);
                    *(u32x4*)(h2w + off) = w;
                }
                ss += __shfl_xor(ss, 16); ss += __shfl_xor(ss, 32);
                if (fq == 0) ssq[(size_t)row * 32 + u.pn * 4 + wc] = ss;
            }
    }
};
__device__ __forceinline__ float row_rstd(const float* ssq, int row) {
    const f32x4* p = (const f32x4*)(ssq + (size_t)row * 32); float s = 0.f;
#pragma unroll
    for (int i = 0; i < 8; ++i) { const f32x4 t = p[i]; s += (t[0] + t[1]) + (t[2] + t[3]); }
    return rsqrtf(s * (1.f / DM) + EPS);
}
struct EpiUp {
    static constexpr bool PERM = true, AFTER_DRAIN = false;
    bf16_t* U; const float* ssq;
    __device__ __forceinline__ void operator()(const f32x4 (&acc)[2][2][4][2], const Unit& u, int wr, int wc, int fr, int fq) const {
        const int row0 = u.pm * 256 + wr * 64 + fr, c0 = u.pn * 256 + wc * 32 + 8 * fq;
#pragma unroll
        for (int ai = 0; ai < 2; ++ai)
#pragma unroll
            for (int m = 0; m < 4; ++m) {
                const int row = row0 + ai * 128 + m * 16; const float rs = row_rstd(ssq, row);
#pragma unroll
                for (int bj = 0; bj < 2; ++bj) {
                    f32x4 v0 = acc[ai][bj][m][0] * rs, v1 = acc[ai][bj][m][1] * rs;
#pragma unroll
                    for (int j = 0; j < 4; ++j) { const float a = fmaxf(v0[j], 0.f), b = fmaxf(v1[j], 0.f); v0[j] = a * a; v1[j] = b * b; }
                    u32x4 w; w.x = cvt_pk_bf16(v0[0], v0[1]); w.y = cvt_pk_bf16(v0[2], v0[3]); w.z = cvt_pk_bf16(v1[0], v1[1]); w.w = cvt_pk_bf16(v1[2], v1[3]);
                    *(u32x4*)(U + (size_t)row * DFF + c0 + bj * 128) = w;
                }
            }
    }
};
struct EpiDown {
    static constexpr bool PERM = true, AFTER_DRAIN = false;
    float* h; float* ssq;
    __device__ __forceinline__ void operator()(const f32x4 (&acc)[2][2][4][2], const Unit& u, int wr, int wc, int fr, int fq) const {
        const int row0 = u.pm * 256 + wr * 64 + fr, c0 = u.pn * 256 + wc * 32 + 8 * fq;
#pragma unroll
        for (int ai = 0; ai < 2; ++ai)
#pragma unroll
            for (int m = 0; m < 4; ++m) {
                const int row = row0 + ai * 128 + m * 16; float ss = 0.f;
#pragma unroll
                for (int bj = 0; bj < 2; ++bj) {
                    const size_t off = (size_t)row * DM + c0 + bj * 128;
                    const f32x4 x0 = *(const f32x4*)(h + off), x1 = *(const f32x4*)(h + off + 4);
                    const f32x4 v0 = acc[ai][bj][m][0] + x0, v1 = acc[ai][bj][m][1] + x1;
                    *(f32x4*)(h + off) = v0; *(f32x4*)(h + off + 4) = v1;
                    ss += (v0[0] * v0[0] + v0[1] * v0[1]) + (v0[2] * v0[2] + v0[3] * v0[3]) + (v1[0] * v1[0] + v1[1] * v1[1]) + (v1[2] * v1[2] + v1[3] * v1[3]);
                }
                ss += __shfl_xor(ss, 16); ss += __shfl_xor(ss, 32);
                if (fq == 0) ssq[(size_t)row * 32 + u.pn * 4 + wc] = ss;
            }
    }
};

__device__ __forceinline__ void transpose_item(const float* W, int K, int N, bf16_t* WT, LAS float* scr, int item, int lane) {
    const int nblk = (N + 63) >> 6, kb = item / nblk, nb = item - kb * nblk, k0 = kb * 64, n0 = nb * 64;
    const int n4 = (lane & 15) * 4, kr = lane >> 4;
#pragma unroll 4
    for (int i = 0; i < 16; ++i) {
        const int kk = i * 4 + kr;
        f32x4 v = (f32x4){0.f, 0.f, 0.f, 0.f};
        if (n0 + n4 < N) v = *(const f32x4*)(W + (size_t)(k0 + kk) * N + n0 + n4);
        LAS float* s = scr + kk * 65 + n4; s[0] = v[0]; s[1] = v[1]; s[2] = v[2]; s[3] = v[3];
    }
    WAVE_LDS_SYNC();
    const int c = lane & 7;
#pragma unroll
    for (int j = 0; j < 8; ++j) {
        const int n = j * 8 + (lane >> 3); const LAS float* s = scr + (8 * c) * 65 + n;
        u32x4 o; o.x = cvt_pk_bf16(s[0], s[65]); o.y = cvt_pk_bf16(s[2 * 65], s[3 * 65]); o.z = cvt_pk_bf16(s[4 * 65], s[5 * 65]); o.w = cvt_pk_bf16(s[6 * 65], s[7 * 65]);
        if (n0 + n < N) *(u32x4*)(WT + (size_t)(n0 + n) * K + k0 + 8 * c) = o;
    }
    WAVE_LDS_SYNC();
}
__device__ __forceinline__ void transpose_weight(const float* W, int K, int N, bf16_t* WT, LAS unsigned char* lds, int gw, int ngw, int wave, int lane) {
    LAS float* scr = (LAS float*)(lds + wave * (64 * 65 * 4));
    const int nitems = (K >> 6) * ((N + 63) >> 6);
    for (int it = gw; it < nitems; it += ngw) transpose_item(W, K, N, WT, scr, it, lane);
}
__device__ __forceinline__ void rms_row_bf16(const float* xrow, const float* w, bf16_t* orow, int lane) {
    const f32x4* xr = (const f32x4*)xrow + lane; f32x4 v[8]; float s = 0.f;
#pragma unroll
    for (int j = 0; j < 8; ++j) { v[j] = xr[64 * j]; s += (v[j][0] * v[j][0] + v[j][1] * v[j][1]) + (v[j][2] * v[j][2] + v[j][3] * v[j][3]); }
    const float rs = rsqrtf(wave_sum(s) * (1.f / DM) + EPS);
    const f32x4* wr = (const f32x4*)w + lane;
    unsigned long long* o8 = (unsigned long long*)orow + lane;
#pragma unroll
    for (int j = 0; j < 8; ++j) { const f32x4 ww = wr[64 * j];
        o8[64 * j] = (unsigned long long)cvt_pk_bf16(v[j][0] * rs * ww[0], v[j][1] * rs * ww[1]) | ((unsigned long long)cvt_pk_bf16(v[j][2] * rs * ww[2], v[j][3] * rs * ww[3]) << 32); }
}

constexpr int P264 = 528, P136 = 272;
constexpr int T264 = 128 * P264, T136 = 128 * P136;

__device__ __forceinline__ float ret_log2_gamma(int h) { return log2f(1.f - exp2f(-5.f - (float)h)); }

__device__ __forceinline__ void conv_silu8(const bf16_t* XBC, const float* cw, const float* cb, int b, int s, int col, float (&o)[8]) {
    { const f32x4 b0 = *(const f32x4*)(cb + col), b1 = *(const f32x4*)(cb + col + 4);
      o[0] = b0[0]; o[1] = b0[1]; o[2] = b0[2]; o[3] = b0[3]; o[4] = b1[0]; o[5] = b1[1]; o[6] = b1[2]; o[7] = b1[3]; }
#pragma unroll
    for (int j = 0; j < 4; ++j) {
        const int sj = s - 3 + j;
        if (sj >= 0) {
            const u32x4 r = *(const u32x4*)(XBC + (size_t)(b * SEQ + sj) * CONVD + col);
            const f32x4 w0 = *(const f32x4*)(cw + j * CONVD + col), w1 = *(const f32x4*)(cw + j * CONVD + col + 4);
            o[0] += w0[0] * bflo(r.x); o[1] += w0[1] * bfhi(r.x); o[2] += w0[2] * bflo(r.y); o[3] += w0[3] * bfhi(r.y);
            o[4] += w1[0] * bflo(r.z); o[5] += w1[1] * bfhi(r.z); o[6] += w1[2] * bflo(r.w); o[7] += w1[3] * bfhi(r.w);
        }
    }
#pragma unroll
    for (int i = 0; i < 8; ++i) o[i] = silu_f(o[i]);
}
__device__ __forceinline__ u32x4 pack8(const float (&o)[8]) {
    u32x4 w; w.x = cvt_pk_bf16(o[0], o[1]); w.y = cvt_pk_bf16(o[2], o[3]); w.z = cvt_pk_bf16(o[4], o[5]); w.w = cvt_pk_bf16(o[6], o[7]); return w;
}

__device__ __forceinline__ void p2_ret_item(const Args& A, LAS unsigned char* lds, int b, int n, int h, int tid, int wave, int lane) {
    const bf16_t* Kg = (const bf16_t*)(A.ws + WS_K); const bf16_t* Vg = (const bf16_t*)(A.ws + WS_V); bf16_t* SR = (bf16_t*)(A.ws + WS_SR);
    LAS unsigned char* vs = lds; LAS unsigned char* ks = lds + T264;
    const int row0 = b * SEQ + n * 128; const float lg = ret_log2_gamma(h);
    for (int i = tid; i < 4096; i += 512) {
        const int r = i >> 5, c = i & 31; const size_t go = (size_t)(row0 + r) * 1024 + h * 256 + c * 8;
        const u32x4 kk = *(const u32x4*)(Kg + go); *(LAS u32x4*)(ks + r * P264 + c * 16) = kk;
        const u32x4 vv = *(const u32x4*)(Vg + go); const float sc = exp2f((float)(127 - r) * lg);
        u32x4 w; w.x = cvt_pk_bf16(bflo(vv.x) * sc, bfhi(vv.x) * sc); w.y = cvt_pk_bf16(bflo(vv.y) * sc, bfhi(vv.y) * sc);
        w.z = cvt_pk_bf16(bflo(vv.z) * sc, bfhi(vv.z) * sc); w.w = cvt_pk_bf16(bflo(vv.w) * sc, bfhi(vv.w) * sc);
        *(LAS u32x4*)(vs + r * P264 + c * 16) = w;
    }
    __syncthreads();
    const int eq = wave >> 1, dh = wave & 1;
    bf16_t* So = SR + (size_t)((b * 16 + n) * 4 + h) * 65536;
#pragma unroll 1
    for (int dq = 0; dq < 2; ++dq) {
        const int d0 = dh * 128 + dq * 64;
        f32x4 acc[4][4];
#pragma unroll
        for (int i = 0; i < 4; ++i)
#pragma unroll
            for (int j = 0; j < 4; ++j) acc[i][j] = (f32x4){0.f, 0.f, 0.f, 0.f};
#pragma unroll
        for (int kt = 0; kt < 4; ++kt) {
            bf16x8 a[4], bb[4];
#pragma unroll
            for (int i = 0; i < 4; ++i) { a[i] = frag_tr(vs, P264, kt * 32, eq * 64 + i * 16, lane); bb[i] = frag_tr(ks, P264, kt * 32, d0 + i * 16, lane); }
#pragma unroll
            for (int i = 0; i < 4; ++i)
#pragma unroll
                for (int j = 0; j < 4; ++j) acc[i][j] = mfma16(a[i], bb[j], acc[i][j]);
        }
#pragma unroll
        for (int i = 0; i < 4; ++i)
#pragma unroll
            for (int j = 0; j < 4; ++j)
#pragma unroll
                for (int jj = 0; jj < 4; ++jj) {
                    const int e = eq * 64 + i * 16 + 4 * (lane >> 4) + jj, d = d0 + j * 16 + (lane & 15);
                    So[e * 256 + d] = f2bf(acc[i][j][jj]);
                }
    }
    __syncthreads();
}

__device__ __forceinline__ void p2_ssd_item(const Args& A, LAS unsigned char* lds, int b, int n, int hq, int tid, int wave, int lane) {
    const bf16_t* XBC = (const bf16_t*)(A.ws + WS_XBC); bf16_t* XC = (bf16_t*)(A.ws + WS_XC); bf16_t* SS = (bf16_t*)(A.ws + WS_SS);
    const float* DT = (const float*)(A.ws + WS_DT); float* ACS = (float*)(A.ws + WS_ACS);
    LAS unsigned char* xsw = lds; LAS unsigned char* Bs = lds + T264;
    LAS float* dts = (LAS float*)(lds + T264 + T136); LAS float* acl = dts + 512; LAS float* wl = acl + 512;
    const int g = hq >> 1, row0 = b * SEQ + n * 128;
    { const int r = tid >> 2, e = tid & 3; dts[tid] = DT[(size_t)(row0 + r) * 16 + hq * 4 + e]; }
    __syncthreads();
    if (tid < 4) { const float a = -__expf(A.a_log[hq * 4 + tid]); float s = 0.f;
        for (int r = 0; r < 128; ++r) { s += dts[r * 4 + tid] * a; acl[r * 4 + tid] = s; } }
    __syncthreads();
    { const int r = tid >> 2, e = tid & 3; const float ac = acl[tid], tot = acl[127 * 4 + e];
      wl[tid] = dts[tid] * __expf(tot - ac); ACS[(size_t)(row0 + r) * 16 + hq * 4 + e] = ac; }
    __syncthreads();
    for (int i = tid; i < 4096; i += 512) {
        const int r = i >> 5, c = i & 31, col = hq * 256 + c * 8; float o[8];
        conv_silu8(XBC, A.conv_w, A.conv_b, b, n * 128 + r, col, o);
        *(u32x4*)(XC + (size_t)(row0 + r) * CONVD + col) = pack8(o);
        const float w = wl[r * 4 + (c >> 3)];
#pragma unroll
        for (int j = 0; j < 8; ++j) o[j] *= w;
        *(LAS u32x4*)(xsw + r * P264 + c * 16) = pack8(o);
    }
    for (int i = tid; i < 2048; i += 512) {
        const int r = i >> 4, c = i & 15, col = 1024 + g * 128 + c * 8; float o[8];
        conv_silu8(XBC, A.conv_w, A.conv_b, b, n * 128 + r, col, o);
        const u32x4 w = pack8(o);
        *(LAS u32x4*)(Bs + r * P136 + c * 16) = w;
        if ((hq & 1) == 0) *(u32x4*)(XC + (size_t)(row0 + r) * CONVD + col) = w;
    }
    if ((hq & 1) == 0) {
        for (int i = tid; i < 2048; i += 512) {
            const int r = i >> 4, c = i & 15, col = 1280 + g * 128 + c * 8; float o[8];
            conv_silu8(XBC, A.conv_w, A.conv_b, b, n * 128 + r, col, o);
            *(u32x4*)(XC + (size_t)(row0 + r) * CONVD + col) = pack8(o);
        }
    }
    __syncthreads();
    const int e = wave >> 1, kh = wave & 1;
    f32x4 acc[4][4];
#pragma unroll
    for (int i = 0; i < 4; ++i)
#pragma unroll
        for (int j = 0; j < 4; ++j) acc[i][j] = (f32x4){0.f, 0.f, 0.f, 0.f};
#pragma unroll
    for (int kt = 0; kt < 4; ++kt) {
        bf16x8 a[4], bb[4];
#pragma unroll
        for (int i = 0; i < 4; ++i) { a[i] = frag_tr(xsw, P264, kt * 32, e * 64 + i * 16, lane); bb[i] = frag_tr(Bs, P136, kt * 32, kh * 64 + i * 16, lane); }
#pragma unroll
        for (int i = 0; i < 4; ++i)
#pragma unroll
            for (int j = 0; j < 4; ++j) acc[i][j] = mfma16(a[i], bb[j], acc[i][j]);
    }
    bf16_t* So = SS + (size_t)((b * 16 + n) * 16 + hq * 4 + e) * 8192;
#pragma unroll
    for (int i = 0; i < 4; ++i)
#pragma unroll
        for (int j = 0; j < 4; ++j)
#pragma unroll
            for (int jj = 0; jj < 4; ++jj) {
                const int p = i * 16 + 4 * (lane >> 4) + jj, k = kh * 64 + j * 16 + (lane & 15);
                So[p * 128 + k] = f2bf(acc[i][j][jj]);
            }
    __syncthreads();
}

__device__ __forceinline__ void p3_scan(const Args& A, int gtid, int gthreads) {
    bf16_t* SR = (bf16_t*)(A.ws + WS_SR); bf16_t* SS = (bf16_t*)(A.ws + WS_SS); const float* ACS = (const float*)(A.ws + WS_ACS);
    for (int it = gtid; it < 131072 + 65536; it += gthreads) {
        bf16_t* base; size_t nstride; float dec[16];
        if (it < 131072) {
            const int bh = it >> 13, off = (it & 8191) * 8, b = bh >> 2, h = bh & 3;
            base = SR + (size_t)(b * 16 * 4 + h) * 65536 + off; nstride = (size_t)4 * 65536;
            const float gd = exp2f(128.f * ret_log2_gamma(h));
#pragma unroll
            for (int n = 0; n < 16; ++n) dec[n] = gd;
        } else {
            const int i2 = it - 131072, bh = i2 >> 10, off = (i2 & 1023) * 8, b = bh >> 4, h = bh & 15;
            base = SS + (size_t)(b * 16 * 16 + h) * 8192 + off; nstride = (size_t)16 * 8192;
#pragma unroll
            for (int n = 0; n < 16; ++n) dec[n] = __expf(ACS[(size_t)(b * SEQ + n * 128 + 127) * 16 + h]);
        }
        u32x4 kv[16];
#pragma unroll
        for (int n = 0; n < 16; ++n) kv[n] = *(const u32x4*)(base + n * nstride);
        float S[8];
#pragma unroll
        for (int j = 0; j < 8; ++j) S[j] = 0.f;
#pragma unroll
        for (int n = 0; n < 16; ++n) {
            *(u32x4*)(base + n * nstride) = pack8(S);
            const float d = dec[n];
            S[0] = d * S[0] + bflo(kv[n].x); S[1] = d * S[1] + bfhi(kv[n].x); S[2] = d * S[2] + bflo(kv[n].y); S[3] = d * S[3] + bfhi(kv[n].y);
            S[4] = d * S[4] + bflo(kv[n].z); S[5] = d * S[5] + bfhi(kv[n].z); S[6] = d * S[6] + bflo(kv[n].w); S[7] = d * S[7] + bfhi(kv[n].w);
        }
    }
}

__device__ __forceinline__ void p4_ret_item(const Args& A, LAS unsigned char* lds, int b, int n, int h, int tid, int wave, int lane) {
    const bf16_t* Qg = (const bf16_t*)(A.ws + WS_Q); const bf16_t* Kg = (const bf16_t*)(A.ws + WS_K); const bf16_t* Vg = (const bf16_t*)(A.ws + WS_V);
    const bf16_t* Gg = (const bf16_t*)(A.ws + WS_G); const bf16_t* SR = (const bf16_t*)(A.ws + WS_SR); bf16_t* MIX = (bf16_t*)(A.ws + WS_HBUF);
    LAS unsigned char* kvs = lds; LAS unsigned char* Ps = lds + 256 * P136;
    const int row0 = b * SEQ + n * 128; const float lg = ret_log2_gamma(h);
    const int fq = lane >> 4, fr = lane & 15;
    for (int i = tid; i < 4096; i += 512) { const int r = i >> 5, c = i & 31;
        *(LAS u32x4*)(kvs + r * P264 + c * 16) = *(const u32x4*)(Kg + (size_t)(row0 + r) * 1024 + h * 256 + c * 8); }
    bf16x8 qf[8];
#pragma unroll
    for (int kt = 0; kt < 8; ++kt) qf[kt] = gfrag_row(Qg + h * 256, 1024, row0 + 16 * wave, kt * 32, lane);
    __syncthreads();
    f32x4 sc[8];
#pragma unroll
    for (int cb = 0; cb < 8; ++cb) {
        sc[cb] = (f32x4){0.f, 0.f, 0.f, 0.f};
        {
#pragma unroll
            for (int kt = 0; kt < 8; ++kt) sc[cb] = mfma16(qf[kt], frag_row(kvs, P264, cb * 16, kt * 32, lane), sc[cb]);
        }
    }
#pragma unroll
    for (int cb = 0; cb < 8; ++cb)
#pragma unroll
        for (int jj = 0; jj < 4; ++jj) {
            const int c = 16 * wave + 4 * fq + jj, m = cb * 16 + fr;
            const float val = (m <= c) ? sc[cb][jj] * exp2f((float)(c - m) * lg) : 0.f;
            *(LAS unsigned short*)(Ps + c * P136 + m * 2) = f2bf(val);
        }
    __syncthreads();
    for (int i = tid; i < 4096; i += 512) { const int r = i & 127, c = i >> 7;
        const u32x4 vv = *(const u32x4*)(Vg + (size_t)(row0 + r) * 1024 + h * 256 + c * 8);
        LAS unsigned short* d = (LAS unsigned short*)(kvs + (c * 8) * P136 + r * 2);
        d[0 * 136] = (unsigned short)(vv.x & 0xffffu); d[1 * 136] = (unsigned short)(vv.x >> 16); d[2 * 136] = (unsigned short)(vv.y & 0xffffu); d[3 * 136] = (unsigned short)(vv.y >> 16);
        d[4 * 136] = (unsigned short)(vv.z & 0xffffu); d[5 * 136] = (unsigned short)(vv.z >> 16); d[6 * 136] = (unsigned short)(vv.w & 0xffffu); d[7 * 136] = (unsigned short)(vv.w >> 16); }
    f32x4 y[16];
#pragma unroll
    for (int eb = 0; eb < 16; ++eb) y[eb] = (f32x4){0.f, 0.f, 0.f, 0.f};
    const bf16_t* Sp = SR + (size_t)((b * 16 + n) * 4 + h) * 65536;
#pragma unroll
    for (int kt = 0; kt < 8; ++kt) {
#pragma unroll
        for (int eh = 0; eh < 2; ++eh) {
            bf16x8 bt[8];
#pragma unroll
            for (int i = 0; i < 8; ++i) bt[i] = gfrag_row(Sp, 256, (eh * 8 + i) * 16, kt * 32, lane);
#pragma unroll
            for (int i = 0; i < 8; ++i) y[eh * 8 + i] = mfma16(qf[kt], bt[i], y[eh * 8 + i]);
            __builtin_amdgcn_sched_barrier(0);
        }
    }
#pragma unroll
    for (int jj = 0; jj < 4; ++jj) { const float qd = exp2f((float)(16 * wave + 4 * fq + jj + 1) * lg);
#pragma unroll
        for (int eb = 0; eb < 16; ++eb) y[eb][jj] *= qd; }
    __syncthreads();
#pragma unroll
    for (int kt = 0; kt < 4; ++kt) {
        {
            const bf16x8 a = frag_row(Ps, P136, 16 * wave, kt * 32, lane);
#pragma unroll
            for (int eb = 0; eb < 16; ++eb) y[eb] = mfma16(a, frag_row(kvs, P136, eb * 16, kt * 32, lane), y[eb]);
        }
    }
    float rs[4];
#pragma unroll
    for (int jj = 0; jj < 4; ++jj) { float s = 0.f;
#pragma unroll
        for (int eb = 0; eb < 16; ++eb) s += y[eb][jj] * y[eb][jj];
        s += __shfl_xor(s, 1); s += __shfl_xor(s, 2); s += __shfl_xor(s, 4); s += __shfl_xor(s, 8);
        rs[jj] = rsqrtf(s * (1.f / 256.f) + EPS); }
#pragma unroll
    for (int eb = 0; eb < 16; ++eb) {
        const int col = h * 256 + eb * 16 + fr; const float wn = A.ret_norm_w[col];
#pragma unroll
        for (int jj = 0; jj < 4; ++jj) { const size_t row = (size_t)(row0 + 16 * wave + 4 * fq + jj);
            const float gs = bf2f(Gg[row * 1024 + col]);
            MIX[row * 2048 + col] = f2bf(y[eb][jj] * rs[jj] * wn * gs); }
    }
    __syncthreads();
}

__device__ __forceinline__ void p4_ssd_item(const Args& A, LAS unsigned char* lds, int b, int n, int g, int tid, int wave, int lane) {
    const bf16_t* XC = (const bf16_t*)(A.ws + WS_XC); const bf16_t* Zg = (const bf16_t*)(A.ws + WS_Z); const bf16_t* SS = (const bf16_t*)(A.ws + WS_SS);
    const float* DT = (const float*)(A.ws + WS_DT); const float* ACS = (const float*)(A.ws + WS_ACS); bf16_t* MIX = (bf16_t*)(A.ws + WS_HBUF);
    LAS unsigned char* xs = lds; LAS unsigned char* R2 = lds + T264;
    LAS float* acl = (LAS float*)(lds + T264 + T136); LAS float* dtl = acl + 1024;
    const int row0 = b * SEQ + n * 128, fq = lane >> 4, fr = lane & 15;
    for (int i = tid; i < 2048; i += 512) { const int r = i >> 4, c = i & 15;
        *(LAS u32x4*)(R2 + r * P136 + c * 16) = *(const u32x4*)(XC + (size_t)(row0 + r) * CONVD + 1024 + g * 128 + c * 8); }
    for (int i = tid; i < 1024; i += 512) { const int r = i >> 3, e = i & 7;
        acl[i] = ACS[(size_t)(row0 + r) * 16 + g * 8 + e]; dtl[i] = DT[(size_t)(row0 + r) * 16 + g * 8 + e]; }
    bf16x8 cf[4];
#pragma unroll
    for (int kt = 0; kt < 4; ++kt) cf[kt] = gfrag_row(XC + 1280 + g * 128, CONVD, row0 + 16 * wave, kt * 32, lane);
    __syncthreads();
    f32x4 cbm[8];
#pragma unroll
    for (int sb = 0; sb < 8; ++sb) {
        cbm[sb] = (f32x4){0.f, 0.f, 0.f, 0.f};
        if (sb <= wave) {
#pragma unroll
            for (int kt = 0; kt < 4; ++kt) cbm[sb] = mfma16(cf[kt], frag_row(R2, P136, sb * 16, kt * 32, lane), cbm[sb]);
        }
    }
    __syncthreads();
    float ssq[4] = {0.f, 0.f, 0.f, 0.f};
#pragma unroll 1
    for (int half = 0; half < 2; ++half) {
        if (half) __syncthreads();
        for (int i = tid; i < 4096; i += 512) { const int r = i >> 5, c = i & 31;
            *(LAS u32x4*)(xs + r * P264 + c * 16) = *(const u32x4*)(XC + (size_t)(row0 + r) * CONVD + g * 512 + half * 256 + c * 8); }
        __syncthreads();
#pragma unroll 1
        for (int e4 = 0; e4 < 4; ++e4) {
            const int e = half * 4 + e4, hh = g * 8 + e;
            f32x4 acc[4];
#pragma unroll
            for (int pb = 0; pb < 4; ++pb) acc[pb] = (f32x4){0.f, 0.f, 0.f, 0.f};
            const bf16_t* Pp = SS + (size_t)((b * 16 + n) * 16 + hh) * 8192;
#pragma unroll
            for (int kt = 0; kt < 4; ++kt)
#pragma unroll
                for (int pb = 0; pb < 4; ++pb) acc[pb] = mfma16(cf[kt], gfrag_row(Pp, 128, pb * 16, kt * 32, lane), acc[pb]);
            float al[4];
#pragma unroll
            for (int jj = 0; jj < 4; ++jj) { al[jj] = acl[(16 * wave + 4 * fq + jj) * 8 + e]; const float s = __expf(al[jj]);
#pragma unroll
                for (int pb = 0; pb < 4; ++pb) acc[pb][jj] *= s; }
            WAVE_LDS_SYNC();
#pragma unroll
            for (int sb = 0; sb < 8; ++sb) {
                const int s = sb * 16 + fr; const float as = acl[s * 8 + e], ds = dtl[s * 8 + e];
#pragma unroll
                for (int jj = 0; jj < 4; ++jj) { const int l = 16 * wave + 4 * fq + jj;
                    const float val = (s <= l) ? cbm[sb][jj] * __expf(al[jj] - as) * ds : 0.f;
                    *(LAS unsigned short*)(R2 + l * P136 + s * 2) = f2bf(val); }
            }
            WAVE_LDS_SYNC();
#pragma unroll
            for (int kt = 0; kt < 4; ++kt) {
                if (kt * 32 <= 16 * wave + 15) {
                    const bf16x8 a = frag_row(R2, P136, 16 * wave, kt * 32, lane);
#pragma unroll
                    for (int pb = 0; pb < 4; ++pb) acc[pb] = mfma16(a, frag_tr(xs, P264, kt * 32, e4 * 64 + pb * 16, lane), acc[pb]);
                }
            }
            const float dsk = A.d_skip[hh];
#pragma unroll
            for (int pb = 0; pb < 4; ++pb) {
                const int pc = e4 * 64 + pb * 16 + fr;
#pragma unroll
                for (int jj = 0; jj < 4; ++jj) { const int l = 16 * wave + 4 * fq + jj;
                    const float xv = bf2f(*(const LAS unsigned short*)(xs + l * P264 + pc * 2));
                    const float zv = bf2f(Zg[(size_t)(row0 + l) * 1024 + g * 512 + half * 256 + pc]);
                    const float yv = (acc[pb][jj] + dsk * xv) * zv;
                    ssq[jj] += yv * yv;
                    MIX[(size_t)(row0 + l) * 2048 + 1024 + g * 512 + half * 256 + pc] = f2bf(yv); }
            }
        }
    }
    asm volatile("s_waitcnt vmcnt(0)" ::: "memory");
    float rs[4];
#pragma unroll
    for (int jj = 0; jj < 4; ++jj) { float s = ssq[jj];
        s += __shfl_xor(s, 1); s += __shfl_xor(s, 2); s += __shfl_xor(s, 4); s += __shfl_xor(s, 8);
        rs[jj] = rsqrtf(s * (1.f / 512.f) + EPS); }
#pragma unroll 1
    for (int e = 0; e < 8; ++e)
#pragma unroll
        for (int pb = 0; pb < 4; ++pb) {
            const int col = g * 512 + e * 64 + pb * 16 + fr; const float wn = A.ssd_norm_w[col];
#pragma unroll
            for (int jj = 0; jj < 4; ++jj) { const size_t idx = (size_t)(row0 + 16 * wave + 4 * fq + jj) * 2048 + 1024 + col;
                MIX[idx] = f2bf(bf2f(MIX[idx]) * rs[jj] * wn); }
        }
    __syncthreads();
}

__device__ unsigned g_bar[128];
__device__ __forceinline__ void own_grid_barrier(unsigned G) {
    asm volatile("s_waitcnt vmcnt(0) lgkmcnt(0)" ::: "memory");
    __syncthreads();
    if (threadIdx.x == 0) {
        __builtin_amdgcn_fence(__ATOMIC_RELEASE, "agent");
        asm volatile("s_waitcnt vmcnt(0)" ::: "memory");
        const unsigned gen = __hip_atomic_load(&g_bar[64], __ATOMIC_RELAXED, __HIP_MEMORY_SCOPE_AGENT);
        const unsigned old = __hip_atomic_fetch_add(&g_bar[0], 1u, __ATOMIC_RELAXED, __HIP_MEMORY_SCOPE_AGENT);
        if (old == G - 1u) {
            __hip_atomic_store(&g_bar[0], 0u, __ATOMIC_RELAXED, __HIP_MEMORY_SCOPE_AGENT);
            __hip_atomic_fetch_add(&g_bar[64], 1u, __ATOMIC_RELEASE, __HIP_MEMORY_SCOPE_AGENT);
        } else {
            unsigned spins = 0;
            while (__hip_atomic_load(&g_bar[64], __ATOMIC_RELAXED, __HIP_MEMORY_SCOPE_AGENT) == gen) { __builtin_amdgcn_s_sleep(2); if (++spins > (1u << 24)) break; }
        }
        __builtin_amdgcn_fence(__ATOMIC_ACQUIRE, "agent");
        asm volatile("s_waitcnt vmcnt(0)" ::: "memory");
    }
    __syncthreads();
    __builtin_amdgcn_fence(__ATOMIC_ACQUIRE, "agent");
    asm volatile("s_waitcnt vmcnt(0)" ::: "memory");
}

__global__ void __launch_bounds__(512, 2) hymba_fwd(Args A) {
    extern __shared__ __attribute__((aligned(16))) unsigned char lds_raw[];
    LAS unsigned char* lds = (LAS unsigned char*)lds_raw;
    cg::grid_group grid = cg::this_grid();
    grid.sync();
#define GRID_SYNC() own_grid_barrier((unsigned)gridDim.x)
#define PHASE_IDS() int tid = threadIdx.x; asm volatile("" : "+v"(tid)); const int lane = tid & 63, wave = __builtin_amdgcn_readfirstlane(tid >> 6); const int gw = bx * 8 + wave, ngw = G * 8; (void)gw; (void)ngw; (void)lane
    const int G = gridDim.x, bx = blockIdx.x;
    unsigned char* ws = A.ws;

#ifndef SK0
    { PHASE_IDS();
    transpose_weight(A.w_in, DM, INW, (bf16_t*)(ws + WS_WIN), lds, gw, ngw, wave, lane);
    transpose_weight(A.w_out, DM, DM, (bf16_t*)(ws + WS_WOUT), lds, gw, ngw, wave, lane);
    for (int m = gw; m < NT; m += ngw) rms_row_bf16(A.x + (size_t)m * DM, A.norm_mix_w, (bf16_t*)(ws + WS_HBUF) + (size_t)m * DM, lane);
    }
#endif
    GRID_SYNC();

#ifndef SK1
    {
        pg8::Gemm g{(const bf16_t*)(ws + WS_HBUF), (const bf16_t*)(ws + WS_WIN), NT, INW_PAD, DM}; pg8::StaticOrder S; S.init(NT, INW_PAD, G, bx);
        EpiInProj E{(bf16_t*)(ws + WS_Q), (bf16_t*)(ws + WS_XBC), (float*)(ws + WS_DT), A.dt_bias};
        pg8::gemm_phase<EpiInProj, pg8::StaticOrder, true, true>(lds, g, S, E);
    }
#endif
    GRID_SYNC();

#ifndef SK2
    { PHASE_IDS();
    for (int it = bx; it < 512; it += G) {
        if (it < 256) p2_ssd_item(A, lds, it >> 6, (it >> 2) & 15, it & 3, tid, wave, lane);
        else { const int j = it - 256; p2_ret_item(A, lds, j >> 6, (j >> 2) & 15, j & 3, tid, wave, lane); }
    }
    }
#endif
    GRID_SYNC();

#ifndef SK3
    { PHASE_IDS(); p3_scan(A, bx * 512 + tid, G * 512); }
#endif
    GRID_SYNC();

#ifndef SK4
    { PHASE_IDS();
    for (int it = bx; it < 384; it += G) {
        if (it < 128) {
#ifndef SK4S
            p4_ssd_item(A, lds, it >> 5, (it >> 1) & 15, it & 1, tid, wave, lane);
#endif
        } else { const int j = it - 128;
#ifndef SK4R
            p4_ret_item(A, lds, j >> 6, (j >> 2) & 15, j & 3, tid, wave, lane);
#endif
        }
    }
    }
#endif
    GRID_SYNC();

#ifndef SK5
    { PHASE_IDS();
    transpose_weight(A.w_up, DM, DFF, (bf16_t*)(ws + WS_WUP), lds, gw, ngw, wave, lane);
    transpose_weight(A.w_down, DFF, DM, (bf16_t*)(ws + WS_WDN), lds, gw, ngw, wave, lane);
    __syncthreads();
    }
    {
        pg8::Gemm g{(const bf16_t*)(ws + WS_HBUF), (const bf16_t*)(ws + WS_WOUT), NT, DM, DM}; pg8::StaticOrder S; S.init(NT, DM, G, bx);
        EpiOutProj E{A.x, A.out, (bf16_t*)(ws + WS_H2W), A.norm_mlp_w, (float*)(ws + WS_SSQ2)};
        pg8::gemm_phase<EpiOutProj, pg8::StaticOrder, true, true>(lds, g, S, E);
    }
#endif
    GRID_SYNC();

#ifndef SK6
    {
        pg8::Gemm g{(const bf16_t*)(ws + WS_H2W), (const bf16_t*)(ws + WS_WUP), NT, DFF, DM}; pg8::StaticOrder S; S.init(NT, DFF, G, bx);
        EpiUp E{(bf16_t*)(ws + WS_U), (const float*)(ws + WS_SSQ2)};
        pg8::gemm_phase<EpiUp, pg8::StaticOrder, true, true>(lds, g, S, E);
    }
#endif
    GRID_SYNC();

#ifndef SK7
    {
        pg8::Gemm g{(const bf16_t*)(ws + WS_U), (const bf16_t*)(ws + WS_WDN), NT, DM, DFF}; pg8::StaticOrder S; S.init(NT, DM, G, bx);
        EpiDown E{A.out, (float*)(ws + WS_SSQ3)};
        pg8::gemm_phase<EpiDown, pg8::StaticOrder, true, true>(lds, g, S, E);
    }
#endif
    GRID_SYNC();

    { PHASE_IDS();
    for (int m = gw; m < NT; m += ngw) {
        const float* sp = (const float*)(ws + WS_SSQ3) + (size_t)m * 32;
        const float s = wave_sum(lane < 32 ? sp[lane] : 0.f);
        const float rs = rsqrtf(s * (1.f / DM) + EPS);
        f32x4* o = (f32x4*)(A.out + (size_t)m * DM) + lane; const f32x4* wv = (const f32x4*)A.norm_final_w + lane;
#pragma unroll
        for (int j = 0; j < 8; ++j) { f32x4 v = o[64 * j]; const f32x4 w = wv[64 * j]; v = v * rs * w; o[64 * j] = v; }
    }
    }
}

extern "C" void kernel_launch(void* const* d_in, const int* in_sizes, int n_in, void* d_out, int out_size, void* d_ws, size_t ws_size, hipStream_t stream) {
    static int grid = 0;
    if (grid == 0) {
        int dev = 0, cus = 0, per_cu = 0;
        hipGetDevice(&dev);
        hipDeviceGetAttribute(&cus, hipDeviceAttributeMultiprocessorCount, dev);
        hipFuncSetAttribute((const void*)hymba_fwd, hipFuncAttributeMaxDynamicSharedMemorySize, LDS_BYTES);
        hipOccupancyMaxActiveBlocksPerMultiprocessor(&per_cu, (const void*)hymba_fwd, 512, LDS_BYTES);
        if (per_cu < 1 || cus < 1 || n_in != 15 || ws_size < 256 * MiB) { fprintf(stderr, "kernel_launch: bad configuration (cus %d per_cu %d n_in %d ws %zu)\n", cus, per_cu, n_in, ws_size); grid = -1; }
        else grid = cus * per_cu;
    }
    if (grid < 0) return;
    Args a{};
    a.x = (const float*)d_in[0]; a.norm_mix_w = (const float*)d_in[1]; a.w_in = (const float*)d_in[2]; a.ret_norm_w = (const float*)d_in[3];
    a.conv_w = (const float*)d_in[4]; a.conv_b = (const float*)d_in[5]; a.dt_bias = (const float*)d_in[6]; a.a_log = (const float*)d_in[7];
    a.d_skip = (const float*)d_in[8]; a.ssd_norm_w = (const float*)d_in[9]; a.w_out = (const float*)d_in[10]; a.norm_mlp_w = (const float*)d_in[11];
    a.w_up = (const float*)d_in[12]; a.w_down = (const float*)d_in[13]; a.norm_final_w = (const float*)d_in[14];
    a.out = (float*)d_out; a.ws = (unsigned char*)d_ws;
    void* args[] = {&a};
    hipError_t e = hipLaunchCooperativeKernel((const void*)hymba_fwd, dim3(grid), dim3(512), args, LDS_BYTES, stream);
    if (e != hipSuccess) fprintf(stderr, "cooperative launch failed: %s (grid %d)\n", hipGetErrorString(e), grid);
}
```

```cpp
#include <hip/hip_runtime.h>
#include <hip/hip_cooperative_groups.h>
#include <cstdio>
#include <cstdint>
namespace cg = cooperative_groups;
namespace pg8 {
#define PG8_LAS __attribute__((address_space(3)))
typedef unsigned short bf16_t;
typedef short bf16x8 __attribute__((ext_vector_type(8)));
typedef float f32x4 __attribute__((ext_vector_type(4)));
typedef unsigned u32x4 __attribute__((ext_vector_type(4)));
constexpr int BM = 256, BK = 64, HALF = 128, HTB = HALF * BK * 2  , STAGE_BYTES = 8 * HTB, NXCD = 8, WGM = 8;

__host__ __device__ __forceinline__ int lds_byte(int r, int c) { const int st = (r >> 4) * 2 + (c >> 5), rr = r & 15, cc = c & 31, ob = rr * 64 + cc * 2; return st * 1024 + (ob ^ (((ob >> 9) & 1) << 5)); }
__host__ __device__ __forceinline__ void stage_rc(int b, int& R, int& C) { const int st = b / 1024, sb = b % 1024, swz = sb ^ (((sb >> 9) & 1) << 5); R = (st >> 1) * 16 + swz / 64; C = (st & 1) * 32 + (swz % 64) / 2; }
__host__ __device__ __forceinline__ int perm32(int rho) { const int n = rho >> 4, i = rho & 15; return 8 * (i >> 2) + 4 * n + (i & 3); }

struct Unit { int pm, pn; };
struct Gemm { const bf16_t* A; const bf16_t* Bt; int M, N, K; };

struct StaticOrder {
    int nM, nN, nwg, G, c;
    __host__ __device__ void init(int M, int N, int G_, int c_) { nM = M / BM; nN = N / BM; nwg = nM * nN; G = G_; c = c_; }
    __host__ __device__ bool next(int i, Unit& u) const {
        const long L = (long)i * G + c; if (L >= nwg) return false;
        int wgid = (int)L; { const int q = nwg / NXCD, r = nwg % NXCD, xcd = wgid % NXCD, off = wgid / NXCD; wgid = (xcd < r ? xcd * (q + 1) : r * (q + 1) + (xcd - r) * q) + off; }
        const int nig = WGM * nN, gid = wgid / nig, fm = gid * WGM, gsz = (nM - fm) < WGM ? (nM - fm) : WGM;
        u.pm = fm + ((wgid % nig) % gsz); u.pn = (wgid % nig) / gsz; return true;
    }
    __device__ __forceinline__ void a_ready(const Unit&) const {}
    __device__ __forceinline__ void done(const Unit&) const {}
};
typedef float f32x2_cv __attribute__((ext_vector_type(2))); typedef __bf16 bf16x2_cv __attribute__((ext_vector_type(2)));
__device__ __forceinline__ unsigned cvt_pk_bf16(float lo, float hi) { const f32x2_cv v = {lo, hi}; const bf16x2_cv b = __builtin_convertvector(v, bf16x2_cv); return __builtin_bit_cast(unsigned, b); }
typedef float f32x2 __attribute__((ext_vector_type(2)));
template <class Epi, class Sched, bool ALIGN_EPI = false, bool SP2 = false>
__device__ __forceinline__ void gemm_phase(PG8_LAS unsigned char* lds, const Gemm g, const Sched& S, const Epi& E) {
    int tid_l = threadIdx.x; asm volatile("" : "+v"(tid_l));
    const int tid = tid_l, wid = __builtin_amdgcn_readfirstlane(tid >> 6), lane = tid & 63, wr = wid >> 2, wc = wid & 3, fr = lane & 15, fq = lane >> 4;
    const int K = g.K, nt = K / BK;
    unsigned voffA[2], voffB[2];
#pragma unroll
    for (int i = 0; i < 2; ++i) { int R, C; stage_rc(tid * 16 + i * 8192, R, C); const int Rb = Epi::PERM ? ((R & ~31) + perm32(R & 31)) : R;
        voffA[i] = (unsigned)(R * K + C) * 2u; voffB[i] = (unsigned)(Rb * K + C) * 2u; }
    const size_t kstep = (size_t)(BK * 2);
    const size_t hstep = (size_t)HALF * K * 2;
    const size_t tstep = 2 * hstep;
    const unsigned ldsw = (unsigned)wid * 1024u;
    const int aoff = lds_byte(wr * 64 + fr, fq * 8), boff = lds_byte(wc * 32 + fr, fq * 8);
#define PG8_SA(b, h) (((b) * 2 + (h)) * HTB)
#define PG8_SB(b, h) ((4 + (b) * 2 + (h)) * HTB)
#define PG8_STAGE(bufoff, gbase, voff) do { _Pragma("unroll") for (int _i = 0; _i < 2; ++_i) \
        __builtin_amdgcn_global_load_lds((const unsigned*)((const char*)(gbase) + (voff)[_i]), (PG8_LAS unsigned*)(lds + (bufoff) + ldsw + _i * 8192), 16, 0, 0); } while (0)
#define PG8_LDA(dst, b, h) do { _Pragma("unroll") for (int m = 0; m < 4; ++m) _Pragma("unroll") for (int k = 0; k < 2; ++k) dst[m][k] = *(const PG8_LAS bf16x8*)(lds + PG8_SA(b, h) + aoff + m * 2048 + k * 1024); } while (0)
#define PG8_LDB(dst, b, h) do { _Pragma("unroll") for (int n = 0; n < 2; ++n) _Pragma("unroll") for (int k = 0; k < 2; ++k) dst[n][k] = *(const PG8_LAS bf16x8*)(lds + PG8_SB(b, h) + boff + n * 2048 + k * 1024); } while (0)
#define PG8_MMA(ai, bj, At, Bt) do { __builtin_amdgcn_s_setprio(1); _Pragma("unroll") for (int m = 0; m < 4; ++m) _Pragma("unroll") for (int n = 0; n < 2; ++n) _Pragma("unroll") for (int k = 0; k < 2; ++k) \
        acc[ai][bj][m][n] = __builtin_amdgcn_mfma_f32_16x16x32_bf16(Bt[n][k], At[m][k], acc[ai][bj][m][n], 0, 0, 0); __builtin_amdgcn_s_setprio(0); } while (0)
#define PG8_WAIT_V(n) asm volatile("s_waitcnt vmcnt(" #n ")" ::: "memory")
#define PG8_WAIT_L(n) asm volatile("s_waitcnt lgkmcnt(" #n ")" ::: "memory")
#define PG8_BAR __builtin_amdgcn_s_barrier()
#define PG8_SCHED __builtin_amdgcn_sched_barrier(0)
    Unit cur, nxt; int ui = 0;
    if (!S.next(0, cur)) return;
    f32x4 acc[2][2][4][2];
#pragma unroll
    for (int a = 0; a < 2; ++a)
#pragma unroll
        for (int b = 0; b < 2; ++b)
#pragma unroll
            for (int m = 0; m < 4; ++m)
#pragma unroll
                for (int n = 0; n < 2; ++n) acc[a][b][m][n] = (f32x4){0.f, 0.f, 0.f, 0.f};
    bf16x8 At[4][2], B0[2][2], B1[2][2];
    const char* cA = (const char*)g.A + (size_t)cur.pm * tstep; const char* cB = (const char*)g.Bt + (size_t)cur.pn * tstep;
    S.a_ready(cur);
    if constexpr (SP2) {
        PG8_STAGE(PG8_SB(0, 0), cB, voffB); PG8_STAGE(PG8_SB(0, 1), cB + hstep, voffB); PG8_STAGE(PG8_SA(0, 0), cA, voffA); PG8_STAGE(PG8_SA(0, 1), cA + hstep, voffA);
        if (wr == 1) PG8_BAR;
        PG8_WAIT_V(2); PG8_BAR;
        PG8_STAGE(PG8_SB(1, 0), cB + kstep, voffB); PG8_STAGE(PG8_SA(1, 0), cA + kstep, voffA); PG8_STAGE(PG8_SB(1, 1), cB + hstep + kstep, voffB);
        PG8_WAIT_V(6); PG8_BAR;
    } else {
        PG8_STAGE(PG8_SB(0, 0), cB, voffB); PG8_STAGE(PG8_SA(0, 0), cA, voffA); PG8_STAGE(PG8_SB(0, 1), cB + hstep, voffB); PG8_STAGE(PG8_SA(0, 1), cA + hstep, voffA);
        if (wr == 1) PG8_BAR;
        PG8_WAIT_V(4); PG8_BAR;
        PG8_STAGE(PG8_SB(1, 0), cB + kstep, voffB); PG8_STAGE(PG8_SA(1, 0), cA + kstep, voffA); PG8_STAGE(PG8_SB(1, 1), cB + hstep + kstep, voffB);
        PG8_WAIT_V(6); PG8_BAR;
    }
    for (;;) {
        const bool has_next = S.next(ui + 1, nxt);
        const char* nA = has_next ? (const char*)g.A + (size_t)nxt.pm * tstep : cA; const char* nB = has_next ? (const char*)g.Bt + (size_t)nxt.pn * tstep : cB;
        for (int t = 0; t < nt; t += 2) {
            const bool last = (t == nt - 2);
            const char* a1 = cA + (size_t)(t + 1) * kstep;
            const char* a2 = last ? nA : cA + (size_t)(t + 2) * kstep; const char* b2 = last ? nB : cB + (size_t)(t + 2) * kstep;
            const char* a3 = a2 + kstep; const char* b3 = b2 + kstep;
            if (last && has_next) S.a_ready(nxt);
            if constexpr (SP2) {
            PG8_LDB(B0, 0, 0); PG8_LDB(B1, 0, 1); PG8_SCHED; PG8_LDA(At, 0, 0); PG8_STAGE(PG8_SA(1, 1), a1 + hstep, voffA);
            PG8_WAIT_V(8); PG8_WAIT_L(0); PG8_BAR; PG8_MMA(0, 0, At, B0); PG8_MMA(0, 1, At, B1); PG8_BAR; PG8_SCHED;
            PG8_LDA(At, 0, 1); PG8_STAGE(PG8_SB(0, 0), b2, voffB); PG8_STAGE(PG8_SB(0, 1), b2 + hstep, voffB); PG8_STAGE(PG8_SA(0, 0), a2, voffA);
            PG8_WAIT_V(8); PG8_WAIT_L(0); PG8_BAR; PG8_MMA(1, 0, At, B0); PG8_MMA(1, 1, At, B1); PG8_BAR; PG8_SCHED;
            PG8_LDB(B0, 1, 0); PG8_LDB(B1, 1, 1); PG8_SCHED; PG8_LDA(At, 1, 0); PG8_STAGE(PG8_SA(0, 1), a2 + hstep, voffA);
            PG8_WAIT_V(8); PG8_WAIT_L(0); PG8_BAR; PG8_MMA(0, 0, At, B0); PG8_MMA(0, 1, At, B1); PG8_BAR; PG8_SCHED;
            PG8_LDA(At, 1, 1); PG8_STAGE(PG8_SB(1, 0), b3, voffB); PG8_STAGE(PG8_SB(1, 1), b3 + hstep, voffB); PG8_STAGE(PG8_SA(1, 0), a3, voffA);
            PG8_WAIT_V(8); PG8_WAIT_L(0); PG8_BAR; PG8_MMA(1, 0, At, B0); PG8_MMA(1, 1, At, B1); PG8_BAR; PG8_SCHED;
            } else {
            PG8_LDB(B0, 0, 0); PG8_SCHED; PG8_LDA(At, 0, 0); PG8_STAGE(PG8_SA(1, 1), a1 + hstep, voffA);
            PG8_WAIT_L(8); PG8_BAR; PG8_WAIT_L(0); PG8_MMA(0, 0, At, B0); PG8_BAR; PG8_SCHED;
            PG8_LDB(B1, 0, 1); PG8_STAGE(PG8_SB(0, 0), b2, voffB);
            PG8_BAR; PG8_WAIT_L(0); PG8_MMA(0, 1, At, B1); PG8_BAR;
            PG8_LDA(At, 0, 1); PG8_STAGE(PG8_SA(0, 0), a2, voffA);
            PG8_BAR; PG8_WAIT_L(0); PG8_MMA(1, 0, At, B0); PG8_BAR; PG8_SCHED;
            PG8_STAGE(PG8_SB(0, 1), b2 + hstep, voffB);
            PG8_WAIT_V(6); PG8_BAR; PG8_MMA(1, 1, At, B1); PG8_BAR;
            PG8_LDB(B0, 1, 0); PG8_SCHED; PG8_LDA(At, 1, 0); PG8_STAGE(PG8_SA(0, 1), a2 + hstep, voffA);
            PG8_WAIT_L(8); PG8_BAR; PG8_WAIT_L(0); PG8_MMA(0, 0, At, B0); PG8_BAR; PG8_SCHED;
            PG8_LDB(B1, 1, 1); PG8_STAGE(PG8_SB(1, 0), b3, voffB);
            PG8_BAR; PG8_WAIT_L(0); PG8_MMA(0, 1, At, B1); PG8_BAR;
            PG8_LDA(At, 1, 1); PG8_STAGE(PG8_SA(1, 0), a3, voffA);
            PG8_BAR; PG8_WAIT_L(0); PG8_MMA(1, 0, At, B0); PG8_BAR; PG8_SCHED;
            PG8_STAGE(PG8_SB(1, 1), b3 + hstep, voffB);
            PG8_WAIT_V(6); PG8_BAR; PG8_MMA(1, 1, At, B1); PG8_BAR;
            }
        }
        if constexpr (ALIGN_EPI) { if (wr == 0) PG8_BAR; }
        if constexpr (!Epi::AFTER_DRAIN) { E(acc, cur, wr, wc, fr, fq); S.done(cur); }
        if (!has_next) break;
#pragma unroll
        for (int a = 0; a < 2; ++a)
#pragma unroll
            for (int b = 0; b < 2; ++b)
#pragma unroll
                for (int m = 0; m < 4; ++m)
#pragma unroll
                    for (int n = 0; n < 2; ++n) acc[a][b][m][n] = (f32x4){0.f, 0.f, 0.f, 0.f};
        cur = nxt; cA = nA; cB = nB; ++ui;
        if constexpr (ALIGN_EPI) { if (wr == 1) PG8_BAR; }
    }
    PG8_WAIT_V(0);
    if constexpr (!ALIGN_EPI) { if (wr == 0) PG8_BAR; }
    PG8_BAR;
    if constexpr (Epi::AFTER_DRAIN) { E.fused(acc, cur, wr, wc, fr, fq, lds, wid, lane); S.done(cur); }
#undef PG8_SA
#undef PG8_SB
#undef PG8_STAGE
#undef PG8_LDA
#undef PG8_LDB
#undef PG8_MMA
#undef PG8_WAIT_V
#undef PG8_WAIT_L
#undef PG8_BAR
#undef PG8_SCHED
}
}

using pg8::bf16_t; using pg8::bf16x8; using pg8::f32x4; using pg8::u32x4; using pg8::Unit; using pg8::cvt_pk_bf16;
#define LAS __attribute__((address_space(3)))
typedef short s16x4 __attribute__((ext_vector_type(4)));

constexpr int NT = 8192;
constexpr int SEQ = 2048, DM = 2048, DFF = 8192, INW = 6672, INW_PAD = 6912;
constexpr int CONVD = 1536;
constexpr float EPS = 1e-6f;
constexpr size_t MiB = 1u << 20;
constexpr size_t WS_HBUF = 0;
constexpr size_t WS_Q = 32 * MiB, WS_K = 48 * MiB, WS_V = 64 * MiB, WS_G = 80 * MiB, WS_Z = 96 * MiB;
constexpr int XB_ST_OFF = 139264 - 64;
constexpr size_t WS_U = 0;
constexpr size_t WS_WUP = 128 * MiB;
constexpr size_t OUT_WIN = 0, OUT_SS = 0, OUT_SR = 16 * MiB;
constexpr size_t WS_WDN = 160 * MiB;
constexpr size_t WS_XBC = 192 * MiB;
constexpr size_t WS_DT = 216 * MiB;
constexpr size_t WS_ACS = 217 * MiB;
constexpr size_t WS_H2W = 192 * MiB;
constexpr size_t WS_XC = 224 * MiB;
constexpr size_t WS_SSQ2 = 224 * MiB;
constexpr size_t WS_SSQ3 = 225 * MiB;
constexpr size_t WS_WOUT = 112 * MiB;
constexpr size_t WS_CTL = 248 * MiB;
constexpr int LDS_BYTES = 139264;
#ifndef REP0
#define REP0 1
#endif
#ifndef REP2
#define REP2 1
#endif
#ifndef REP4
#define REP4 1
#endif
#ifndef REP5
#define REP5 1
#endif
#ifndef REP6
#define REP6 1
#endif

struct Args {
    const float* x; const float* norm_mix_w; const float* w_in; const float* ret_norm_w; const float* conv_w; const float* conv_b;
    const float* dt_bias; const float* a_log; const float* d_skip; const float* ssd_norm_w; const float* w_out; const float* norm_mlp_w;
    const float* w_up; const float* w_down; const float* norm_final_w;
    float* out; unsigned char* ws;
};

__device__ __forceinline__ float bf2f(unsigned short b) { return __builtin_bit_cast(float, (unsigned)b << 16); }
__device__ __forceinline__ float bflo(unsigned w) { return __builtin_bit_cast(float, w << 16); }
__device__ __forceinline__ float bfhi(unsigned w) { return __builtin_bit_cast(float, w & 0xffff0000u); }
__device__ __forceinline__ unsigned short f2bf(float f) { return (unsigned short)(cvt_pk_bf16(f, 0.f) & 0xffffu); }
__device__ __forceinline__ float silu_f(float x) { return x / (1.f + __expf(-x)); }
__device__ __forceinline__ float wave_sum(float v) {
#pragma unroll
    for (int o = 1; o < 64; o <<= 1) v += __shfl_xor(v, o);
    return v;
}
__device__ __forceinline__ f32x4 mfma16(bf16x8 a, bf16x8 b, f32x4 c) { return __builtin_amdgcn_mfma_f32_16x16x32_bf16(a, b, c, 0, 0, 0); }
__device__ __forceinline__ bf16x8 frag_row(const LAS unsigned char* base, int pitchB, int r0, int c0, int lane) {
    return *(const LAS bf16x8*)(base + (r0 + (lane & 15)) * pitchB + (c0 + 8 * (lane >> 4)) * 2);
}
__device__ __forceinline__ bf16x8 frag_tr(const LAS unsigned char* base, int pitchB, int k0, int c0, int lane) {
    const int g = lane >> 4, q = (lane & 15) >> 2, p = lane & 3;
    const LAS unsigned char* a = base + (k0 + 8 * g + q) * pitchB + (c0 + 4 * p) * 2;
    const s16x4 lo = __builtin_amdgcn_ds_read_tr16_b64_v4i16((LAS s16x4*)a);
    const s16x4 hi = __builtin_amdgcn_ds_read_tr16_b64_v4i16((LAS s16x4*)(a + 4 * pitchB));
    bf16x8 r; r[0] = lo[0]; r[1] = lo[1]; r[2] = lo[2]; r[3] = lo[3]; r[4] = hi[0]; r[5] = hi[1]; r[6] = hi[2]; r[7] = hi[3];
    return r;
}
__device__ __forceinline__ bf16x8 gfrag_row(const bf16_t* base, int ld, int r0, int c0, int lane) {
    return *(const bf16x8*)(base + (size_t)(r0 + (lane & 15)) * ld + c0 + 8 * (lane >> 4));
}
#define WAVE_LDS_SYNC() asm volatile("s_waitcnt lgkmcnt(0)" ::: "memory")

struct EpiInProj {
    static constexpr bool PERM = true, AFTER_DRAIN = false;
    bf16_t *qkvgz, *xbc; float* dt; const float* dt_bias;
    __device__ __forceinline__ void operator()(const f32x4 (&acc)[2][2][4][2], const Unit& u, int wr, int wc, int fr, int fq) const {
        const int row0 = u.pm * 256 + wr * 64 + fr, pn = u.pn, cw = wc * 32 + 8 * fq;
        if (pn < 8) {
            bf16_t* base = qkvgz + (size_t)(pn >> 2) * (size_t)(NT * 1024); const float sc = (pn < 4) ? 1.f : 0.0625f; const int hc = (pn & 3) * 256;
            float invf[2][4];
#pragma unroll
            for (int n = 0; n < 2; ++n)
#pragma unroll
                for (int j = 0; j < 4; ++j) invf[n][j] = exp2f(-(float)(cw + 4 * n + j) * (13.287712379549449f / 128.f)) * 0.15915494309189535f;
#pragma unroll
            for (int ai = 0; ai < 2; ++ai)
#pragma unroll
                for (int m = 0; m < 4; ++m) {
                    const int row = row0 + ai * 128 + m * 16; const float pos = (float)(row & (SEQ - 1));
                    float o1[8], o2[8];
#pragma unroll
                    for (int n = 0; n < 2; ++n)
#pragma unroll
                        for (int j = 0; j < 4; ++j) {
                            float rev = pos * invf[n][j]; rev -= floorf(rev);
                            const float s = __builtin_amdgcn_sinf(rev), c = __builtin_amdgcn_cosf(rev);
                            const float x1 = acc[ai][0][m][n][j], x2 = acc[ai][1][m][n][j];
                            o1[n * 4 + j] = (x1 * c - x2 * s) * sc; o2[n * 4 + j] = (x1 * s + x2 * c) * sc;
                        }
                    u32x4 w1, w2;
                    w1.x = cvt_pk_bf16(o1[0], o1[1]); w1.y = cvt_pk_bf16(o1[2], o1[3]); w1.z = cvt_pk_bf16(o1[4], o1[5]); w1.w = cvt_pk_bf16(o1[6], o1[7]);
                    w2.x = cvt_pk_bf16(o2[0], o2[1]); w2.y = cvt_pk_bf16(o2[2], o2[3]); w2.z = cvt_pk_bf16(o2[4], o2[5]); w2.w = cvt_pk_bf16(o2[6], o2[7]);
                    bf16_t* rp = base + (size_t)row * 1024 + hc + cw;
                    *(u32x4*)rp = w1; *(u32x4*)(rp + 128) = w2;
                }
        } else if (pn < 26) {
            bf16_t* base; int ld, hc; bool act;
            if (pn < 20) { base = qkvgz + (size_t)(pn >> 2) * (size_t)(NT * 1024); act = (pn >= 12); ld = 1024; hc = (pn & 3) * 256; }
            else { base = xbc; act = false; ld = CONVD; hc = (pn - 20) * 256; }
#pragma unroll
            for (int ai = 0; ai < 2; ++ai)
#pragma unroll
                for (int m = 0; m < 4; ++m) {
                    bf16_t* rp = base + (size_t)(row0 + ai * 128 + m * 16) * ld + hc + cw;
#pragma unroll
                    for (int bj = 0; bj < 2; ++bj) {
                        f32x4 v0 = acc[ai][bj][m][0], v1 = acc[ai][bj][m][1];
                        if (act) {
#pragma unroll
                            for (int j = 0; j < 4; ++j) { v0[j] = silu_f(v0[j]); v1[j] = silu_f(v1[j]); }
                        }
                        u32x4 w; w.x = cvt_pk_bf16(v0[0], v0[1]); w.y = cvt_pk_bf16(v0[2], v0[3]); w.z = cvt_pk_bf16(v1[0], v1[1]); w.w = cvt_pk_bf16(v1[2], v1[3]);
                        *(u32x4*)(rp + bj * 128) = w;
                    }
                }
        } else {
            if (wc == 0 && fq < 2) {
#pragma unroll
                for (int ai = 0; ai < 2; ++ai)
#pragma unroll
                    for (int m = 0; m < 4; ++m) {
                        const int row = row0 + ai * 128 + m * 16;
#pragma unroll
                        for (int n = 0; n < 2; ++n) {
                            f32x4 o;
#pragma unroll
                            for (int j = 0; j < 4; ++j) { const float xv = acc[ai][0][m][n][j] + dt_bias[8 * fq + 4 * n + j]; o[j] = (xv > 20.f) ? xv : log1pf(__expf(xv)); }
                            *(f32x4*)(dt + (size_t)row * 16 + 8 * fq + 4 * n) = o;
                        }
                    }
            }
        }
    }
};
struct EpiOutProj {
    static constexpr bool PERM = true, AFTER_DRAIN = false;
    const float* x; float* h2; bf16_t* h2w; const float* nw; float* ssq;
    __device__ __forceinline__ void operator()(const f32x4 (&acc)[2][2][4][2], const Unit& u, int wr, int wc, int fr, int fq) const {
        const int row0 = u.pm * 256 + wr * 64 + fr, c0 = u.pn * 256 + wc * 32 + 8 * fq;
#pragma unroll
        for (int ai = 0; ai < 2; ++ai)
#pragma unroll
            for (int m = 0; m < 4; ++m) {
                const int row = row0 + ai * 128 + m * 16; float ss = 0.f;
#pragma unroll
                for (int bj = 0; bj < 2; ++bj) {
                    const size_t off = (size_t)row * DM + c0 + bj * 128;
                    const f32x4 x0 = *(const f32x4*)(x + off), x1 = *(const f32x4*)(x + off + 4);
                    const f32x4 v0 = acc[ai][bj][m][0] + x0, v1 = acc[ai][bj][m][1] + x1;
                    *(f32x4*)(h2 + off) = v0; *(f32x4*)(h2 + off + 4) = v1;
                    ss += (v0[0] * v0[0] + v0[1] * v0[1]) + (v0[2] * v0[2] + v0[3] * v0[3]) + (v1[0] * v1[0] + v1[1] * v1[1]) + (v1[2] * v1[2] + v1[3] * v1[3]);
                    const f32x4 w0 = *(const f32x4*)(nw + c0 + bj * 128), w1 = *(const f32x4*)(nw + c0 + bj * 128 + 4);
                    u32x4 w; w.x = cvt_pk_bf16(v0[0] * w0[0], v0[1] * w0[1]); w.y = cvt_pk_bf16(v0[2] * w0[2], v0[3] * w0[3]);
                    w.z = cvt_pk_bf16(v1[0] * w1[0], v1[1] * w1[1]); w.w = cvt_pk_bf16(v1[2] * w1[2], v1[3] * w1[3]);
                    *(u32x4*)(h2w + off) = w;
                }
                ss += __shfl_xor(ss, 16); ss += __shfl_xor(ss, 32);
                if (fq == 0) ssq[(size_t)row * 32 + u.pn * 4 + wc] = ss;
            }
    }
};
__device__ __forceinline__ float row_rstd(const float* ssq, int row) {
    const f32x4* p = (const f32x4*)(ssq + (size_t)row * 32); float s = 0.f;
#pragma unroll
    for (int i = 0; i < 8; ++i) { const f32x4 t = p[i]; s += (t[0] + t[1]) + (t[2] + t[3]); }
    return rsqrtf(s * (1.f / DM) + EPS);
}
struct EpiUp {
    static constexpr bool PERM = true, AFTER_DRAIN = false;
    bf16_t* U; const float* ssq;
    __device__ __forceinline__ void operator()(const f32x4 (&acc)[2][2][4][2], const Unit& u, int wr, int wc, int fr, int fq) const {
        const int row0 = u.pm * 256 + wr * 64 + fr, c0 = u.pn * 256 + wc * 32 + 8 * fq;
#pragma unroll
        for (int ai = 0; ai < 2; ++ai)
#pragma unroll
            for (int m = 0; m < 4; ++m) {
                const int row = row0 + ai * 128 + m * 16; const float rs = row_rstd(ssq, row);
#pragma unroll
                for (int bj = 0; bj < 2; ++bj) {
                    f32x4 v0 = acc[ai][bj][m][0] * rs, v1 = acc[ai][bj][m][1] * rs;
#pragma unroll
                    for (int j = 0; j < 4; ++j) { const float a = fmaxf(v0[j], 0.f), b = fmaxf(v1[j], 0.f); v0[j] = a * a; v1[j] = b * b; }
                    u32x4 w; w.x = cvt_pk_bf16(v0[0], v0[1]); w.y = cvt_pk_bf16(v0[2], v0[3]); w.z = cvt_pk_bf16(v1[0], v1[1]); w.w = cvt_pk_bf16(v1[2], v1[3]);
                    *(u32x4*)(U + (size_t)row * DFF + c0 + bj * 128) = w;
                }
            }
    }
};
struct EpiDown {
    static constexpr bool PERM = true, AFTER_DRAIN = false;
    float* h; float* ssq;
    __device__ __forceinline__ void operator()(const f32x4 (&acc)[2][2][4][2], const Unit& u, int wr, int wc, int fr, int fq) const {
        const int row0 = u.pm * 256 + wr * 64 + fr, c0 = u.pn * 256 + wc * 32 + 8 * fq;
#pragma unroll
        for (int ai = 0; ai < 2; ++ai)
#pragma unroll
            for (int m = 0; m < 4; ++m) {
                const int row = row0 + ai * 128 + m * 16; float ss = 0.f;
#pragma unroll
                for (int bj = 0; bj < 2; ++bj) {
                    const size_t off = (size_t)row * DM + c0 + bj * 128;
                    const f32x4 x0 = *(const f32x4*)(h + off), x1 = *(const f32x4*)(h + off + 4);
                    const f32x4 v0 = acc[ai][bj][m][0] + x0, v1 = acc[ai][bj][m][1] + x1;
                    *(f32x4*)(h + off) = v0; *(f32x4*)(h + off + 4) = v1;
                    ss += (v0[0] * v0[0] + v0[1] * v0[1]) + (v0[2] * v0[2] + v0[3] * v0[3]) + (v1[0] * v1[0] + v1[1] * v1[1]) + (v1[2] * v1[2] + v1[3] * v1[3]);
                }
                ss += __shfl_xor(ss, 16); ss += __shfl_xor(ss, 32);
                if (fq == 0) ssq[(size_t)row * 32 + u.pn * 4 + wc] = ss;
            }
    }
};

__device__ __forceinline__ void transpose_item(const float* W, int K, int N, bf16_t* WT, LAS float* scr, int item, int lane) {
    const int nblk = (N + 63) >> 6, kb = item / nblk, nb = item - kb * nblk, k0 = kb * 64, n0 = nb * 64;
    const int n4 = (lane & 15) * 4, kr = lane >> 4;
#pragma unroll 4
    for (int i = 0; i < 16; ++i) {
        const int kk = i * 4 + kr;
        f32x4 v = (f32x4){0.f, 0.f, 0.f, 0.f};
        if (n0 + n4 < N) v = *(const f32x4*)(W + (size_t)(k0 + kk) * N + n0 + n4);
        LAS float* s = scr + kk * 65 + n4; s[0] = v[0]; s[1] = v[1]; s[2] = v[2]; s[3] = v[3];
    }
    WAVE_LDS_SYNC();
    const int c = lane & 7;
#pragma unroll
    for (int j = 0; j < 8; ++j) {
        const int n = j * 8 + (lane >> 3); const LAS float* s = scr + (8 * c) * 65 + n;
        u32x4 o; o.x = cvt_pk_bf16(s[0], s[65]); o.y = cvt_pk_bf16(s[2 * 65], s[3 * 65]); o.z = cvt_pk_bf16(s[4 * 65], s[5 * 65]); o.w = cvt_pk_bf16(s[6 * 65], s[7 * 65]);
        if (n0 + n < N) *(u32x4*)(WT + (size_t)(n0 + n) * K + k0 + 8 * c) = o;
    }
    WAVE_LDS_SYNC();
}
__device__ __forceinline__ void transpose_weight(const float* W, int K, int N, bf16_t* WT, LAS unsigned char* lds, int gw, int ngw, int wave, int lane) {
    LAS float* scr = (LAS float*)(lds + wave * (64 * 65 * 4));
    const int nitems = (K >> 6) * ((N + 63) >> 6);
    for (int it = gw; it < nitems; it += ngw) transpose_item(W, K, N, WT, scr, it, lane);
}
__device__ __forceinline__ void rms_row_bf16(const float* xrow, const float* w, bf16_t* orow, int lane) {
    const f32x4* xr = (const f32x4*)xrow + lane; f32x4 v[8]; float s = 0.f;
#pragma unroll
    for (int j = 0; j < 8; ++j) { v[j] = xr[64 * j]; s += (v[j][0] * v[j][0] + v[j][1] * v[j][1]) + (v[j][2] * v[j][2] + v[j][3] * v[j][3]); }
    const float rs = rsqrtf(wave_sum(s) * (1.f / DM) + EPS);
    const f32x4* wr = (const f32x4*)w + lane;
    unsigned long long* o8 = (unsigned long long*)orow + lane;
#pragma unroll
    for (int j = 0; j < 8; ++j) { const f32x4 ww = wr[64 * j];
        o8[64 * j] = (unsigned long long)cvt_pk_bf16(v[j][0] * rs * ww[0], v[j][1] * rs * ww[1]) | ((unsigned long long)cvt_pk_bf16(v[j][2] * rs * ww[2], v[j][3] * rs * ww[3]) << 32); }
}

constexpr int P264 = 528, P136 = 272;
constexpr int T264 = 128 * P264, T136 = 128 * P136;

__device__ __forceinline__ float ret_log2_gamma(int h) { return log2f(1.f - exp2f(-5.f - (float)h)); }

__device__ __forceinline__ void conv_silu8(const bf16_t* XBC, const float* cw, const float* cb, int b, int s, int col, float (&o)[8]) {
    { const f32x4 b0 = *(const f32x4*)(cb + col), b1 = *(const f32x4*)(cb + col + 4);
      o[0] = b0[0]; o[1] = b0[1]; o[2] = b0[2]; o[3] = b0[3]; o[4] = b1[0]; o[5] = b1[1]; o[6] = b1[2]; o[7] = b1[3]; }
#pragma unroll
    for (int j = 0; j < 4; ++j) {
        const int sj = s - 3 + j;
        if (sj >= 0) {
            const u32x4 r = *(const u32x4*)(XBC + (size_t)(b * SEQ + sj) * CONVD + col);
            const f32x4 w0 = *(const f32x4*)(cw + j * CONVD + col), w1 = *(const f32x4*)(cw + j * CONVD + col + 4);
            o[0] += w0[0] * bflo(r.x); o[1] += w0[1] * bfhi(r.x); o[2] += w0[2] * bflo(r.y); o[3] += w0[3] * bfhi(r.y);
            o[4] += w1[0] * bflo(r.z); o[5] += w1[1] * bfhi(r.z); o[6] += w1[2] * bflo(r.w); o[7] += w1[3] * bfhi(r.w);
        }
    }
#pragma unroll
    for (int i = 0; i < 8; ++i) o[i] = silu_f(o[i]);
}
__device__ __forceinline__ u32x4 pack8(const float (&o)[8]) {
    u32x4 w; w.x = cvt_pk_bf16(o[0], o[1]); w.y = cvt_pk_bf16(o[2], o[3]); w.z = cvt_pk_bf16(o[4], o[5]); w.w = cvt_pk_bf16(o[6], o[7]); return w;
}

__device__ __forceinline__ void p2_ret_item(const Args& A, LAS unsigned char* lds, int b, int n, int h, int tid, int wave, int lane) {
    const bf16_t* Kg = (const bf16_t*)(A.ws + WS_K); const bf16_t* Vg = (const bf16_t*)(A.ws + WS_V); bf16_t* SR = (bf16_t*)((unsigned char*)A.out + OUT_SR);
    LAS unsigned char* vs = lds; LAS unsigned char* ks = lds + T264;
    const int row0 = b * SEQ + n * 128; const float lg = ret_log2_gamma(h);
    for (int i = tid; i < 4096; i += 512) {
        const int r = i >> 5, c = i & 31; const size_t go = (size_t)(row0 + r) * 1024 + h * 256 + c * 8;
        const u32x4 kk = *(const u32x4*)(Kg + go); *(LAS u32x4*)(ks + r * P264 + c * 16) = kk;
        const u32x4 vv = *(const u32x4*)(Vg + go); const float sc = exp2f((float)(127 - r) * lg);
        u32x4 w; w.x = cvt_pk_bf16(bflo(vv.x) * sc, bfhi(vv.x) * sc); w.y = cvt_pk_bf16(bflo(vv.y) * sc, bfhi(vv.y) * sc);
        w.z = cvt_pk_bf16(bflo(vv.z) * sc, bfhi(vv.z) * sc); w.w = cvt_pk_bf16(bflo(vv.w) * sc, bfhi(vv.w) * sc);
        *(LAS u32x4*)(vs + r * P264 + c * 16) = w;
    }
    __syncthreads();
    const int eq = wave >> 1, dh = wave & 1;
    bf16_t* So = SR + (size_t)((b * 16 + n) * 4 + h) * 65536;
#pragma unroll 1
    for (int dq = 0; dq < 2; ++dq) {
        const int d0 = dh * 128 + dq * 64;
        f32x4 acc[4][4];
#pragma unroll
        for (int i = 0; i < 4; ++i)
#pragma unroll
            for (int j = 0; j < 4; ++j) acc[i][j] = (f32x4){0.f, 0.f, 0.f, 0.f};
#pragma unroll
        for (int kt = 0; kt < 4; ++kt) {
            bf16x8 a[4], bb[4];
#pragma unroll
            for (int i = 0; i < 4; ++i) { a[i] = frag_tr(vs, P264, kt * 32, eq * 64 + i * 16, lane); bb[i] = frag_tr(ks, P264, kt * 32, d0 + i * 16, lane); }
#pragma unroll
            for (int i = 0; i < 4; ++i)
#pragma unroll
                for (int j = 0; j < 4; ++j) acc[i][j] = mfma16(a[i], bb[j], acc[i][j]);
        }
#pragma unroll
        for (int i = 0; i < 4; ++i)
#pragma unroll
            for (int j = 0; j < 4; ++j)
#pragma unroll
                for (int jj = 0; jj < 4; ++jj) {
                    const int e = eq * 64 + i * 16 + 4 * (lane >> 4) + jj, d = d0 + j * 16 + (lane & 15);
                    So[e * 256 + d] = f2bf(acc[i][j][jj]);
                }
    }
    __syncthreads();
}

__device__ __forceinline__ void p2_ssd_item(const Args& A, LAS unsigned char* lds, int b, int n, int hq, int tid, int wave, int lane) {
    const bf16_t* XBC = (const bf16_t*)(A.ws + WS_XBC); bf16_t* XC = (bf16_t*)(A.ws + WS_XC); bf16_t* SS = (bf16_t*)((unsigned char*)A.out + OUT_SS);
    const float* DT = (const float*)(A.ws + WS_DT); float* ACS = (float*)(A.ws + WS_ACS);
    LAS unsigned char* xsw = lds; LAS unsigned char* Bs = lds + T264;
    LAS float* dts = (LAS float*)(lds + T264 + T136); LAS float* acl = dts + 512; LAS float* wl = acl + 512;
    const int g = hq >> 1, row0 = b * SEQ + n * 128;
    { const int r = tid >> 2, e = tid & 3; dts[tid] = DT[(size_t)(row0 + r) * 16 + hq * 4 + e]; }
    __syncthreads();
    if (tid < 4) { const float a = -__expf(A.a_log[hq * 4 + tid]); float s = 0.f;
        for (int r = 0; r < 128; ++r) { s += dts[r * 4 + tid] * a; acl[r * 4 + tid] = s; } }
    __syncthreads();
    { const int r = tid >> 2, e = tid & 3; const float ac = acl[tid], tot = acl[127 * 4 + e];
      wl[tid] = dts[tid] * __expf(tot - ac); ACS[(size_t)(row0 + r) * 16 + hq * 4 + e] = ac; }
    __syncthreads();
    for (int i = tid; i < 4096; i += 512) {
        const int r = i >> 5, c = i & 31, col = hq * 256 + c * 8; float o[8];
        conv_silu8(XBC, A.conv_w, A.conv_b, b, n * 128 + r, col, o);
        *(u32x4*)(XC + (size_t)(row0 + r) * CONVD + col) = pack8(o);
        const float w = wl[r * 4 + (c >> 3)];
#pragma unroll
        for (int j = 0; j < 8; ++j) o[j] *= w;
        *(LAS u32x4*)(xsw + r * P264 + c * 16) = pack8(o);
    }
    for (int i = tid; i < 2048; i += 512) {
        const int r = i >> 4, c = i & 15, col = 1024 + g * 128 + c * 8; float o[8];
        conv_silu8(XBC, A.conv_w, A.conv_b, b, n * 128 + r, col, o);
        const u32x4 w = pack8(o);
        *(LAS u32x4*)(Bs + r * P136 + c * 16) = w;
        if ((hq & 1) == 0) *(u32x4*)(XC + (size_t)(row0 + r) * CONVD + col) = w;
    }
    if ((hq & 1) == 0) {
        for (int i = tid; i < 2048; i += 512) {
            const int r = i >> 4, c = i & 15, col = 1280 + g * 128 + c * 8; float o[8];
            conv_silu8(XBC, A.conv_w, A.conv_b, b, n * 128 + r, col, o);
            *(u32x4*)(XC + (size_t)(row0 + r) * CONVD + col) = pack8(o);
        }
    }
    __syncthreads();
    const int e = wave >> 1, kh = wave & 1;
    f32x4 acc[4][4];
#pragma unroll
    for (int i = 0; i < 4; ++i)
#pragma unroll
        for (int j = 0; j < 4; ++j) acc[i][j] = (f32x4){0.f, 0.f, 0.f, 0.f};
#pragma unroll
    for (int kt = 0; kt < 4; ++kt) {
        bf16x8 a[4], bb[4];
#pragma unroll
        for (int i = 0; i < 4; ++i) { a[i] = frag_tr(xsw, P264, kt * 32, e * 64 + i * 16, lane); bb[i] = frag_tr(Bs, P136, kt * 32, kh * 64 + i * 16, lane); }
#pragma unroll
        for (int i = 0; i < 4; ++i)
#pragma unroll
            for (int j = 0; j < 4; ++j) acc[i][j] = mfma16(a[i], bb[j], acc[i][j]);
    }
    bf16_t* So = SS + (size_t)((b * 16 + n) * 16 + hq * 4 + e) * 8192;
#pragma unroll
    for (int i = 0; i < 4; ++i)
#pragma unroll
        for (int j = 0; j < 4; ++j)
#pragma unroll
            for (int jj = 0; jj < 4; ++jj) {
                const int p = i * 16 + 4 * (lane >> 4) + jj, k = kh * 64 + j * 16 + (lane & 15);
                So[p * 128 + k] = f2bf(acc[i][j][jj]);
            }
    __syncthreads();
}

__device__ __forceinline__ void p3_scan(const Args& A, int gtid, int gthreads) {
    bf16_t* SR = (bf16_t*)((unsigned char*)A.out + OUT_SR); bf16_t* SS = (bf16_t*)((unsigned char*)A.out + OUT_SS); const float* ACS = (const float*)(A.ws + WS_ACS);
    for (int it = gtid; it < 131072 + 65536; it += gthreads) {
        bf16_t* base; size_t nstride; float dec[16];
        if (it < 131072) {
            const int bh = it >> 13, off = (it & 8191) * 8, b = bh >> 2, h = bh & 3;
            base = SR + (size_t)(b * 16 * 4 + h) * 65536 + off; nstride = (size_t)4 * 65536;
            const float gd = exp2f(128.f * ret_log2_gamma(h));
#pragma unroll
            for (int n = 0; n < 16; ++n) dec[n] = gd;
        } else {
            const int i2 = it - 131072, bh = i2 >> 10, off = (i2 & 1023) * 8, b = bh >> 4, h = bh & 15;
            base = SS + (size_t)(b * 16 * 16 + h) * 8192 + off; nstride = (size_t)16 * 8192;
#pragma unroll
            for (int n = 0; n < 16; ++n) dec[n] = __expf(ACS[(size_t)(b * SEQ + n * 128 + 127) * 16 + h]);
        }
        u32x4 kv[16];
#pragma unroll
        for (int n = 0; n < 16; ++n) kv[n] = *(const u32x4*)(base + n * nstride);
        float S[8];
#pragma unroll
        for (int j = 0; j < 8; ++j) S[j] = 0.f;
#pragma unroll
        for (int n = 0; n < 16; ++n) {
            *(u32x4*)(base + n * nstride) = pack8(S);
            const float d = dec[n];
            S[0] = d * S[0] + bflo(kv[n].x); S[1] = d * S[1] + bfhi(kv[n].x); S[2] = d * S[2] + bflo(kv[n].y); S[3] = d * S[3] + bfhi(kv[n].y);
            S[4] = d * S[4] + bflo(kv[n].z); S[5] = d * S[5] + bfhi(kv[n].z); S[6] = d * S[6] + bflo(kv[n].w); S[7] = d * S[7] + bfhi(kv[n].w);
        }
    }
}

__device__ __forceinline__ void p4_ret_item(const Args& A, LAS unsigned char* lds, int b, int n, int h, int tid, int wave, int lane) {
    const bf16_t* Qg = (const bf16_t*)(A.ws + WS_Q); const bf16_t* Kg = (const bf16_t*)(A.ws + WS_K); const bf16_t* Vg = (const bf16_t*)(A.ws + WS_V);
    const bf16_t* Gg = (const bf16_t*)(A.ws + WS_G); const bf16_t* SR = (const bf16_t*)((unsigned char*)A.out + OUT_SR); bf16_t* MIX = (bf16_t*)(A.ws + WS_HBUF);
    LAS unsigned char* kvs = lds; LAS unsigned char* Ps = lds + 256 * P136;
    const int row0 = b * SEQ + n * 128; const float lg = ret_log2_gamma(h);
    const int fq = lane >> 4, fr = lane & 15;
    for (int i = tid; i < 4096; i += 512) { const int r = i >> 5, c = i & 31;
        *(LAS u32x4*)(kvs + r * P264 + c * 16) = *(const u32x4*)(Kg + (size_t)(row0 + r) * 1024 + h * 256 + c * 8); }
    bf16x8 qf[8];
#pragma unroll
    for (int kt = 0; kt < 8; ++kt) qf[kt] = gfrag_row(Qg + h * 256, 1024, row0 + 16 * wave, kt * 32, lane);
    __syncthreads();
    f32x4 sc[8];
#pragma unroll
    for (int cb = 0; cb < 8; ++cb) {
        sc[cb] = (f32x4){0.f, 0.f, 0.f, 0.f};
        {
#pragma unroll
            for (int kt = 0; kt < 8; ++kt) sc[cb] = mfma16(qf[kt], frag_row(kvs, P264, cb * 16, kt * 32, lane), sc[cb]);
        }
    }
#pragma unroll
    for (int cb = 0; cb < 8; ++cb)
#pragma unroll
        for (int jj = 0; jj < 4; ++jj) {
            const int c = 16 * wave + 4 * fq + jj, m = cb * 16 + fr;
            const float val = (m <= c) ? sc[cb][jj] * exp2f((float)(c - m) * lg) : 0.f;
            *(LAS unsigned short*)(Ps + c * P136 + m * 2) = f2bf(val);
        }
    __syncthreads();
    for (int i = tid; i < 4096; i += 512) { const int r = i & 127, c = i >> 7;
        const u32x4 vv = *(const u32x4*)(Vg + (size_t)(row0 + r) * 1024 + h * 256 + c * 8);
        LAS unsigned short* d = (LAS unsigned short*)(kvs + (c * 8) * P136 + r * 2);
        d[0 * 136] = (unsigned short)(vv.x & 0xffffu); d[1 * 136] = (unsigned short)(vv.x >> 16); d[2 * 136] = (unsigned short)(vv.y & 0xffffu); d[3 * 136] = (unsigned short)(vv.y >> 16);
        d[4 * 136] = (unsigned short)(vv.z & 0xffffu); d[5 * 136] = (unsigned short)(vv.z >> 16); d[6 * 136] = (unsigned short)(vv.w & 0xffffu); d[7 * 136] = (unsigned short)(vv.w >> 16); }
    f32x4 y[16];
#pragma unroll
    for (int eb = 0; eb < 16; ++eb) y[eb] = (f32x4){0.f, 0.f, 0.f, 0.f};
    const bf16_t* Sp = SR + (size_t)((b * 16 + n) * 4 + h) * 65536;
#pragma unroll
    for (int kt = 0; kt < 8; ++kt) {
#pragma unroll
        for (int eh = 0; eh < 2; ++eh) {
            bf16x8 bt[8];
#pragma unroll
            for (int i = 0; i < 8; ++i) bt[i] = gfrag_row(Sp, 256, (eh * 8 + i) * 16, kt * 32, lane);
#pragma unroll
            for (int i = 0; i < 8; ++i) y[eh * 8 + i] = mfma16(qf[kt], bt[i], y[eh * 8 + i]);
            __builtin_amdgcn_sched_barrier(0);
        }
    }
#pragma unroll
    for (int jj = 0; jj < 4; ++jj) { const float qd = exp2f((float)(16 * wave + 4 * fq + jj + 1) * lg);
#pragma unroll
        for (int eb = 0; eb < 16; ++eb) y[eb][jj] *= qd; }
    __syncthreads();
#pragma unroll
    for (int kt = 0; kt < 4; ++kt) {
        {
            const bf16x8 a = frag_row(Ps, P136, 16 * wave, kt * 32, lane);
#pragma unroll
            for (int eb = 0; eb < 16; ++eb) y[eb] = mfma16(a, frag_row(kvs, P136, eb * 16, kt * 32, lane), y[eb]);
        }
    }
    float rs[4];
#pragma unroll
    for (int jj = 0; jj < 4; ++jj) { float s = 0.f;
#pragma unroll
        for (int eb = 0; eb < 16; ++eb) s += y[eb][jj] * y[eb][jj];
        s += __shfl_xor(s, 1); s += __shfl_xor(s, 2); s += __shfl_xor(s, 4); s += __shfl_xor(s, 8);
        rs[jj] = rsqrtf(s * (1.f / 256.f) + EPS); }
#pragma unroll
    for (int eb = 0; eb < 16; ++eb) {
        const int col = h * 256 + eb * 16 + fr; const float wn = A.ret_norm_w[col];
#pragma unroll
        for (int jj = 0; jj < 4; ++jj) { const size_t row = (size_t)(row0 + 16 * wave + 4 * fq + jj);
            const float gs = bf2f(Gg[row * 1024 + col]);
            MIX[row * 2048 + col] = f2bf(y[eb][jj] * rs[jj] * wn * gs); }
    }
    __syncthreads();
}

__device__ __forceinline__ void p4_ssd_item(const Args& A, LAS unsigned char* lds, int b, int n, int g, int tid, int wave, int lane) {
    const bf16_t* XC = (const bf16_t*)(A.ws + WS_XC); const bf16_t* Zg = (const bf16_t*)(A.ws + WS_Z); const bf16_t* SS = (const bf16_t*)((unsigned char*)A.out + OUT_SS);
    const float* DT = (const float*)(A.ws + WS_DT); const float* ACS = (const float*)(A.ws + WS_ACS); bf16_t* MIX = (bf16_t*)(A.ws + WS_HBUF);
    LAS unsigned char* xs = lds; LAS unsigned char* R2 = lds + T264;
    LAS float* acl = (LAS float*)(lds + T264 + T136); LAS float* dtl = acl + 1024;
    const int row0 = b * SEQ + n * 128, fq = lane >> 4, fr = lane & 15;
    for (int i = tid; i < 2048; i += 512) { const int r = i >> 4, c = i & 15;
        *(LAS u32x4*)(R2 + r * P136 + c * 16) = *(const u32x4*)(XC + (size_t)(row0 + r) * CONVD + 1024 + g * 128 + c * 8); }
    for (int i = tid; i < 1024; i += 512) { const int r = i >> 3, e = i & 7;
        acl[i] = ACS[(size_t)(row0 + r) * 16 + g * 8 + e]; dtl[i] = DT[(size_t)(row0 + r) * 16 + g * 8 + e]; }
    bf16x8 cf[4];
#pragma unroll
    for (int kt = 0; kt < 4; ++kt) cf[kt] = gfrag_row(XC + 1280 + g * 128, CONVD, row0 + 16 * wave, kt * 32, lane);
    __syncthreads();
    f32x4 cbm[8];
#pragma unroll
    for (int sb = 0; sb < 8; ++sb) {
        cbm[sb] = (f32x4){0.f, 0.f, 0.f, 0.f};
        if (sb <= wave) {
#pragma unroll
            for (int kt = 0; kt < 4; ++kt) cbm[sb] = mfma16(cf[kt], frag_row(R2, P136, sb * 16, kt * 32, lane), cbm[sb]);
        }
    }
    __syncthreads();
    float ssq[4] = {0.f, 0.f, 0.f, 0.f};
#pragma unroll 1
    for (int half = 0; half < 2; ++half) {
        if (half) __syncthreads();
        for (int i = tid; i < 4096; i += 512) { const int r = i >> 5, c = i & 31;
            *(LAS u32x4*)(xs + r * P264 + c * 16) = *(const u32x4*)(XC + (size_t)(row0 + r) * CONVD + g * 512 + half * 256 + c * 8); }
        __syncthreads();
#pragma unroll 1
        for (int e4 = 0; e4 < 4; ++e4) {
            const int e = half * 4 + e4, hh = g * 8 + e;
            f32x4 acc[4];
#pragma unroll
            for (int pb = 0; pb < 4; ++pb) acc[pb] = (f32x4){0.f, 0.f, 0.f, 0.f};
            const bf16_t* Pp = SS + (size_t)((b * 16 + n) * 16 + hh) * 8192;
#pragma unroll
            for (int kt = 0; kt < 4; ++kt)
#pragma unroll
                for (int pb = 0; pb < 4; ++pb) acc[pb] = mfma16(cf[kt], gfrag_row(Pp, 128, pb * 16, kt * 32, lane), acc[pb]);
            float al[4];
#pragma unroll
            for (int jj = 0; jj < 4; ++jj) { al[jj] = acl[(16 * wave + 4 * fq + jj) * 8 + e]; const float s = __expf(al[jj]);
#pragma unroll
                for (int pb = 0; pb < 4; ++pb) acc[pb][jj] *= s; }
            WAVE_LDS_SYNC();
#pragma unroll
            for (int sb = 0; sb < 8; ++sb) {
                const int s = sb * 16 + fr; const float as = acl[s * 8 + e], ds = dtl[s * 8 + e];
#pragma unroll
                for (int jj = 0; jj < 4; ++jj) { const int l = 16 * wave + 4 * fq + jj;
                    const float val = (s <= l) ? cbm[sb][jj] * __expf(al[jj] - as) * ds : 0.f;
                    *(LAS unsigned short*)(R2 + l * P136 + s * 2) = f2bf(val); }
            }
            WAVE_LDS_SYNC();
#pragma unroll
            for (int kt = 0; kt < 4; ++kt) {
                if (kt * 32 <= 16 * wave + 15) {
                    const bf16x8 a = frag_row(R2, P136, 16 * wave, kt * 32, lane);
#pragma unroll
                    for (int pb = 0; pb < 4; ++pb) acc[pb] = mfma16(a, frag_tr(xs, P264, kt * 32, e4 * 64 + pb * 16, lane), acc[pb]);
                }
            }
            const float dsk = A.d_skip[hh];
#pragma unroll
            for (int pb = 0; pb < 4; ++pb) {
                const int pc = e4 * 64 + pb * 16 + fr;
#pragma unroll
                for (int jj = 0; jj < 4; ++jj) { const int l = 16 * wave + 4 * fq + jj;
                    const float xv = bf2f(*(const LAS unsigned short*)(xs + l * P264 + pc * 2));
                    const float zv = bf2f(Zg[(size_t)(row0 + l) * 1024 + g * 512 + half * 256 + pc]);
                    const float yv = (acc[pb][jj] + dsk * xv) * zv;
                    ssq[jj] += yv * yv;
                    MIX[(size_t)(row0 + l) * 2048 + 1024 + g * 512 + half * 256 + pc] = f2bf(yv); }
            }
        }
    }
    asm volatile("s_waitcnt vmcnt(0)" ::: "memory");
    float rs[4];
#pragma unroll
    for (int jj = 0; jj < 4; ++jj) { float s = ssq[jj];
        s += __shfl_xor(s, 1); s += __shfl_xor(s, 2); s += __shfl_xor(s, 4); s += __shfl_xor(s, 8);
        rs[jj] = rsqrtf(s * (1.f / 512.f) + EPS); }
#pragma unroll 1
    for (int e = 0; e < 8; ++e)
#pragma unroll
        for (int pb = 0; pb < 4; ++pb) {
            const int col = g * 512 + e * 64 + pb * 16 + fr; const float wn = A.ssd_norm_w[col];
#pragma unroll
            for (int jj = 0; jj < 4; ++jj) { const size_t idx = (size_t)(row0 + 16 * wave + 4 * fq + jj) * 2048 + 1024 + col;
                MIX[idx] = f2bf(bf2f(MIX[idx]) * rs[jj] * wn); }
        }
    __syncthreads();
}

#define XB_TMO      128
#define XB_XCNT(j)  (256  + 64 * (j))
#define XB_XSUB(j)  (1280 + 64 * (j))
#define XB_XGEN(j)  (2304 + 64 * (j))
#define XB_TOP      3328
#define XB_TOPGEN   3392
#define XCD_BAR_WORDS 3456
#define XB_SPIN_CAP (1u << 18)

__device__ __forceinline__ unsigned xb_ld(unsigned* p)              { return __hip_atomic_load(p, __ATOMIC_RELAXED, __HIP_MEMORY_SCOPE_AGENT); }
__device__ __forceinline__ unsigned xb_add(unsigned* p, unsigned v) { return __hip_atomic_fetch_add(p, v, __ATOMIC_RELAXED, __HIP_MEMORY_SCOPE_AGENT); }
__device__ __forceinline__ unsigned xb_xcc_id() { return (unsigned)__builtin_amdgcn_s_getreg((3 << 11) | 20) & 0xFu; }
#define XB_SPIN(cond, bar) do { unsigned _sp = 0; while (cond) { __builtin_amdgcn_s_sleep(1); \
    if ((++_sp & 255u) == 0u) { if (xb_ld(&(bar)[XB_TMO])) break; if (_sp > XB_SPIN_CAP) { atomicAdd(&(bar)[XB_TMO], 1u); break; } } } } while (0)

struct XcdBarrier {
    unsigned* bar; unsigned x;
    volatile LAS unsigned* st;
};

__device__ __forceinline__ XcdBarrier xcd_barrier_post(unsigned* bar, volatile LAS unsigned* st) {
    XcdBarrier b; b.bar = bar; b.x = xb_xcc_id(); b.st = st;
    if (threadIdx.x == 0) (void)xb_add(&bar[XB_XCNT(b.x)], 1u);
    return b;
}
__device__ __forceinline__ void xcd_barrier_complete(unsigned* bar, unsigned x, unsigned& nloc, unsigned& nx) {
    const unsigned G = gridDim.x * gridDim.y * gridDim.z;
    unsigned sum, cnt, mine, sp = 0u;
    for (;;) {
        sum = 0u; cnt = 0u; mine = 0u;
#pragma unroll
        for (unsigned j = 0; j < 16; ++j) { const unsigned c = xb_ld(&bar[XB_XCNT(j)]); sum += c; cnt += (c > 0u) ? 1u : 0u; mine = (j == x) ? c : mine; }
        if (sum == G) break;
        __builtin_amdgcn_s_sleep(1);
        if ((++sp & 255u) == 0u) { if (xb_ld(&bar[XB_TMO])) break; if (sp > XB_SPIN_CAP) { atomicAdd(&bar[XB_TMO], 1u); break; } }
    }
    nloc = mine > 0u ? mine : 1u; nx = cnt > 0u ? cnt : 1u;
}

__device__ __forceinline__ void xcd_barrier(const XcdBarrier& b) {
    asm volatile("s_waitcnt vmcnt(0)" ::: "memory");
    __syncthreads();
    if (threadIdx.x == 0) {
        unsigned* bar = b.bar;
        __builtin_amdgcn_s_waitcnt(0);
        unsigned nloc = b.st[0], nx = b.st[1];
        if (nloc == 0u) { xcd_barrier_complete(bar, b.x, nloc, nx); b.st[0] = nloc; b.st[1] = nx; }
        const unsigned old = xb_add(&bar[XB_XSUB(b.x)], 1u);
        const unsigned gen = old / nloc;
        if (old + 1u == (gen + 1u) * nloc) {
            __builtin_amdgcn_fence(__ATOMIC_RELEASE, "agent");
            asm volatile("s_waitcnt vmcnt(0)" ::: "memory");
            const unsigned og = xb_add(&bar[XB_TOP], 1u);
            const unsigned tg = og / nx;
            if (og + 1u == (tg + 1u) * nx) xb_add(&bar[XB_TOPGEN], 1u);
            else XB_SPIN(xb_ld(&bar[XB_TOPGEN]) == tg, bar);
            __builtin_amdgcn_fence(__ATOMIC_ACQUIRE, "agent");
            xb_add(&bar[XB_XGEN(b.x)], 1u);
            asm volatile("s_waitcnt vmcnt(0)" ::: "memory");
        } else {
            XB_SPIN(xb_ld(&bar[XB_XGEN(b.x)]) == gen, bar);
            __builtin_amdgcn_fence(__ATOMIC_ACQUIRE, "agent");
            asm volatile("s_waitcnt vmcnt(0)" ::: "memory");
        }
    }
    __syncthreads();
}


__global__ void __launch_bounds__(512, 2) hymba_fwd(Args A) {
    extern __shared__ __attribute__((aligned(16))) unsigned char lds_raw[];
    LAS unsigned char* lds = (LAS unsigned char*)lds_raw;
    cg::grid_group grid = cg::this_grid();
    { volatile LAS unsigned* st = (volatile LAS unsigned*)(lds + XB_ST_OFF); if (threadIdx.x < 2) st[threadIdx.x] = 0u; }
    __syncthreads();
    XcdBarrier xbar = xcd_barrier_post((unsigned*)(A.ws + WS_CTL), (volatile LAS unsigned*)(lds + XB_ST_OFF));
    grid.sync();
#define GRID_SYNC() xcd_barrier(xbar)
#define PHASE_IDS() int tid = threadIdx.x; asm volatile("" : "+v"(tid)); const int lane = tid & 63, wave = __builtin_amdgcn_readfirstlane(tid >> 6); const int gw = bx * 8 + wave, ngw = G * 8; (void)gw; (void)ngw; (void)lane
    const int G = gridDim.x, bx = blockIdx.x;
    unsigned char* ws = A.ws;

#ifndef SK0
    for (int rep_ = 0; rep_ < REP0; ++rep_) { PHASE_IDS();
    transpose_weight(A.w_in, DM, INW, (bf16_t*)((unsigned char*)A.out + OUT_WIN), lds, gw, ngw, wave, lane);
    transpose_weight(A.w_out, DM, DM, (bf16_t*)(ws + WS_WOUT), lds, gw, ngw, wave, lane);
    for (int m = gw; m < NT; m += ngw) rms_row_bf16(A.x + (size_t)m * DM, A.norm_mix_w, (bf16_t*)(ws + WS_HBUF) + (size_t)m * DM, lane);
    }
#endif
    GRID_SYNC();

#ifndef SK1
    {
        pg8::Gemm g{(const bf16_t*)(ws + WS_HBUF), (const bf16_t*)((unsigned char*)A.out + OUT_WIN), NT, INW_PAD, DM}; pg8::StaticOrder S; S.init(NT, INW_PAD, G, bx);
        EpiInProj E{(bf16_t*)(ws + WS_Q), (bf16_t*)(ws + WS_XBC), (float*)(ws + WS_DT), A.dt_bias};
        pg8::gemm_phase<EpiInProj, pg8::StaticOrder, true, true>(lds, g, S, E);
    }
    {
        PHASE_IDS();
        const int nwg1 = (NT / 256) * (INW_PAD / 256), full = nwg1 % G, nidle = (full == 0) ? G : G - full;
        const int ib = (full == 0) ? bx : bx - full;
        if (ib >= 0) {
            __syncthreads();
            transpose_weight(A.w_up, DM, DFF, (bf16_t*)(ws + WS_WUP), lds, ib * 8 + wave, nidle * 8, wave, lane);
            transpose_weight(A.w_down, DFF, DM, (bf16_t*)(ws + WS_WDN), lds, ib * 8 + wave, nidle * 8, wave, lane);
        }
    }
#endif
    GRID_SYNC();

#ifndef SK2
    for (int rep_ = 0; rep_ < REP2; ++rep_) { PHASE_IDS();
    for (int it = bx; it < 512; it += G) {
        if (it < 256) p2_ssd_item(A, lds, it >> 6, (it >> 2) & 15, it & 3, tid, wave, lane);
        else { const int j = it - 256; p2_ret_item(A, lds, j >> 6, (j >> 2) & 15, j & 3, tid, wave, lane); }
    }
    }
#endif
    GRID_SYNC();

#ifndef SK3
    { PHASE_IDS(); p3_scan(A, bx * 512 + tid, G * 512); }
#endif
    GRID_SYNC();

#ifndef SK4
    for (int rep_ = 0; rep_ < REP4; ++rep_) { PHASE_IDS();
    for (int it = bx; it < 384; it += G) {
        if (it < 128) {
#ifndef SK4S
            p4_ssd_item(A, lds, it >> 5, (it >> 1) & 15, it & 1, tid, wave, lane);
#endif
        } else { const int j = it - 128;
#ifndef SK4R
            p4_ret_item(A, lds, j >> 6, (j >> 2) & 15, j & 3, tid, wave, lane);
#endif
        }
    }
    }
#endif
    GRID_SYNC();

#ifndef SK5
    {
        pg8::Gemm g{(const bf16_t*)(ws + WS_HBUF), (const bf16_t*)(ws + WS_WOUT), NT, DM, DM}; pg8::StaticOrder S; S.init(NT, DM, G, bx);
        EpiOutProj E{A.x, A.out, (bf16_t*)(ws + WS_H2W), A.norm_mlp_w, (float*)(ws + WS_SSQ2)};
        pg8::gemm_phase<EpiOutProj, pg8::StaticOrder, true, true>(lds, g, S, E);
    }
#endif
    GRID_SYNC();

#ifndef SK6
    {
        pg8::Gemm g{(const bf16_t*)(ws + WS_H2W), (const bf16_t*)(ws + WS_WUP), NT, DFF, DM}; pg8::StaticOrder S; S.init(NT, DFF, G, bx);
        EpiUp E{(bf16_t*)(ws + WS_U), (const float*)(ws + WS_SSQ2)};
        for (int rep_ = 0; rep_ < REP6; ++rep_) pg8::gemm_phase<EpiUp, pg8::StaticOrder, true, true>(lds, g, S, E);
    }
#endif
    GRID_SYNC();

#ifndef SK7
    {
        pg8::Gemm g{(const bf16_t*)(ws + WS_U), (const bf16_t*)(ws + WS_WDN), NT, DM, DFF}; pg8::StaticOrder S; S.init(NT, DM, G, bx);
        EpiDown E{A.out, (float*)(ws + WS_SSQ3)};
        pg8::gemm_phase<EpiDown, pg8::StaticOrder, true, true>(lds, g, S, E);
    }
#endif
    GRID_SYNC();

    { PHASE_IDS();
    for (int m = gw; m < NT; m += ngw) {
        const float* sp = (const float*)(ws + WS_SSQ3) + (size_t)m * 32;
        const float s = wave_sum(lane < 32 ? sp[lane] : 0.f);
        const float rs = rsqrtf(s * (1.f / DM) + EPS);
        f32x4* o = (f32x4*)(A.out + (size_t)m * DM) + lane; const f32x4* wv = (const f32x4*)A.norm_final_w + lane;
#pragma unroll
        for (int j = 0; j < 8; ++j) { f32x4 v = o[64 * j]; const f32x4 w = wv[64 * j]; v = v * rs * w; o[64 * j] = v; }
    }
    }
}

extern "C" void kernel_launch(void* const* d_in, const int* in_sizes, int n_in, void* d_out, int out_size, void* d_ws, size_t ws_size, hipStream_t stream) {
    static int grid = 0;
    if (grid == 0) {
        int dev = 0, cus = 0, per_cu = 0;
        hipGetDevice(&dev);
        hipDeviceGetAttribute(&cus, hipDeviceAttributeMultiprocessorCount, dev);
        hipFuncSetAttribute((const void*)hymba_fwd, hipFuncAttributeMaxDynamicSharedMemorySize, LDS_BYTES);
        hipOccupancyMaxActiveBlocksPerMultiprocessor(&per_cu, (const void*)hymba_fwd, 512, LDS_BYTES);
        if (per_cu < 1 || cus < 1 || n_in != 15 || ws_size < 256 * MiB) { fprintf(stderr, "kernel_launch: bad configuration (cus %d per_cu %d n_in %d ws %zu)\n", cus, per_cu, n_in, ws_size); grid = -1; }
        else grid = cus * per_cu;
    }
    if (grid < 0) return;
    Args a{};
    a.x = (const float*)d_in[0]; a.norm_mix_w = (const float*)d_in[1]; a.w_in = (const float*)d_in[2]; a.ret_norm_w = (const float*)d_in[3];
    a.conv_w = (const float*)d_in[4]; a.conv_b = (const float*)d_in[5]; a.dt_bias = (const float*)d_in[6]; a.a_log = (const float*)d_in[7];
    a.d_skip = (const float*)d_in[8]; a.ssd_norm_w = (const float*)d_in[9]; a.w_out = (const float*)d_in[10]; a.norm_mlp_w = (const float*)d_in[11];
    a.w_up = (const float*)d_in[12]; a.w_down = (const float*)d_in[13]; a.norm_final_w = (const float*)d_in[14];
    a.out = (float*)d_out; a.ws = (unsigned char*)d_ws;
    if (hipMemsetAsync((char*)d_ws + WS_CTL, 0, 16384, stream) != hipSuccess) { fprintf(stderr, "memset failed\n"); return; }
    void* args[] = {&a};
    hipError_t e = hipLaunchCooperativeKernel((const void*)hymba_fwd, dim3(grid), dim3(512), args, LDS_BYTES, stream);
    if (e != hipSuccess) fprintf(stderr, "cooperative launch failed: %s (grid %d)\n", hipGetErrorString(e), grid);
}
```

```cpp
#include <hip/hip_runtime.h>
#include <hip/hip_cooperative_groups.h>
#include <cstdio>
#include <cstdint>
namespace cg = cooperative_groups;
namespace pg8 {
#define PG8_LAS __attribute__((address_space(3)))
typedef unsigned short bf16_t;
typedef short bf16x8 __attribute__((ext_vector_type(8)));
typedef float f32x4 __attribute__((ext_vector_type(4)));
typedef unsigned u32x4 __attribute__((ext_vector_type(4)));
constexpr int BM = 256, BK = 64, HALF = 128, HTB = HALF * BK * 2  , STAGE_BYTES = 8 * HTB, NXCD = 8, WGM = 8;

__host__ __device__ __forceinline__ int lds_byte(int r, int c) { const int st = (r >> 4) * 2 + (c >> 5), rr = r & 15, cc = c & 31, ob = rr * 64 + cc * 2; return st * 1024 + (ob ^ (((ob >> 9) & 1) << 5)); }
__host__ __device__ __forceinline__ void stage_rc(int b, int& R, int& C) { const int st = b / 1024, sb = b % 1024, swz = sb ^ (((sb >> 9) & 1) << 5); R = (st >> 1) * 16 + swz / 64; C = (st & 1) * 32 + (swz % 64) / 2; }
__host__ __device__ __forceinline__ int perm32(int rho) { const int n = rho >> 4, i = rho & 15; return 8 * (i >> 2) + 4 * n + (i & 3); }

struct Unit { int pm, pn; };
struct Gemm { const bf16_t* A; const bf16_t* Bt; int M, N, K; };

struct StaticOrder {
    int nM, nN, nwg, G, c;
    __host__ __device__ void init(int M, int N, int G_, int c_) { nM = M / BM; nN = N / BM; nwg = nM * nN; G = G_; c = c_; }
    __host__ __device__ bool next(int i, Unit& u) const {
        const long L = (long)i * G + c; if (L >= nwg) return false;
        int wgid = (int)L; { const int q = nwg / NXCD, r = nwg % NXCD, xcd = wgid % NXCD, off = wgid / NXCD; wgid = (xcd < r ? xcd * (q + 1) : r * (q + 1) + (xcd - r) * q) + off; }
        const int nig = WGM * nN, gid = wgid / nig, fm = gid * WGM, gsz = (nM - fm) < WGM ? (nM - fm) : WGM;
        u.pm = fm + ((wgid % nig) % gsz); u.pn = (wgid % nig) / gsz; return true;
    }
    __device__ __forceinline__ void a_ready(const Unit&) const {}
    __device__ __forceinline__ void done(const Unit&) const {}
};
typedef float f32x2_cv __attribute__((ext_vector_type(2))); typedef __bf16 bf16x2_cv __attribute__((ext_vector_type(2)));
__device__ __forceinline__ unsigned cvt_pk_bf16(float lo, float hi) { const f32x2_cv v = {lo, hi}; const bf16x2_cv b = __builtin_convertvector(v, bf16x2_cv); return __builtin_bit_cast(unsigned, b); }
typedef float f32x2 __attribute__((ext_vector_type(2)));
template <class Epi, class Sched, bool ALIGN_EPI = false, bool SP2 = false>
__device__ __forceinline__ void gemm_phase(PG8_LAS unsigned char* lds, const Gemm g, const Sched& S, const Epi& E) {
    int tid_l = threadIdx.x; asm volatile("" : "+v"(tid_l));
    const int tid = tid_l, wid = __builtin_amdgcn_readfirstlane(tid >> 6), lane = tid & 63, wr = wid >> 2, wc = wid & 3, fr = lane & 15, fq = lane >> 4;
    const int K = g.K, nt = K / BK;
    unsigned voffA[2], voffB[2];
#pragma unroll
    for (int i = 0; i < 2; ++i) { int R, C; stage_rc(tid * 16 + i * 8192, R, C); const int Rb = Epi::PERM ? ((R & ~31) + perm32(R & 31)) : R;
        voffA[i] = (unsigned)(R * K + C) * 2u; voffB[i] = (unsigned)(Rb * K + C) * 2u; }
    const size_t kstep = (size_t)(BK * 2);
    const size_t hstep = (size_t)HALF * K * 2;
    const size_t tstep = 2 * hstep;
    const unsigned ldsw = (unsigned)wid * 1024u;
    const int aoff = lds_byte(wr * 64 + fr, fq * 8), boff = lds_byte(wc * 32 + fr, fq * 8);
#define PG8_SA(b, h) (((b) * 2 + (h)) * HTB)
#define PG8_SB(b, h) ((4 + (b) * 2 + (h)) * HTB)
#define PG8_STAGE(bufoff, gbase, voff) do { _Pragma("unroll") for (int _i = 0; _i < 2; ++_i) \
        __builtin_amdgcn_global_load_lds((const unsigned*)((const char*)(gbase) + (voff)[_i]), (PG8_LAS unsigned*)(lds + (bufoff) + ldsw + _i * 8192), 16, 0, 0); } while (0)
#define PG8_LDA(dst, b, h) do { _Pragma("unroll") for (int m = 0; m < 4; ++m) _Pragma("unroll") for (int k = 0; k < 2; ++k) dst[m][k] = *(const PG8_LAS bf16x8*)(lds + PG8_SA(b, h) + aoff + m * 2048 + k * 1024); } while (0)
#define PG8_LDB(dst, b, h) do { _Pragma("unroll") for (int n = 0; n < 2; ++n) _Pragma("unroll") for (int k = 0; k < 2; ++k) dst[n][k] = *(const PG8_LAS bf16x8*)(lds + PG8_SB(b, h) + boff + n * 2048 + k * 1024); } while (0)
#define PG8_MMA(ai, bj, At, Bt) do { __builtin_amdgcn_s_setprio(1); _Pragma("unroll") for (int m = 0; m < 4; ++m) _Pragma("unroll") for (int n = 0; n < 2; ++n) _Pragma("unroll") for (int k = 0; k < 2; ++k) \
        acc[ai][bj][m][n] = __builtin_amdgcn_mfma_f32_16x16x32_bf16(Bt[n][k], At[m][k], acc[ai][bj][m][n], 0, 0, 0); __builtin_amdgcn_s_setprio(0); } while (0)
#define PG8_WAIT_V(n) asm volatile("s_waitcnt vmcnt(" #n ")" ::: "memory")
#define PG8_WAIT_L(n) asm volatile("s_waitcnt lgkmcnt(" #n ")" ::: "memory")
#define PG8_BAR __builtin_amdgcn_s_barrier()
#define PG8_SCHED __builtin_amdgcn_sched_barrier(0)
    Unit cur, nxt; int ui = 0;
    if (!S.next(0, cur)) return;
    f32x4 acc[2][2][4][2];
#pragma unroll
    for (int a = 0; a < 2; ++a)
#pragma unroll
        for (int b = 0; b < 2; ++b)
#pragma unroll
            for (int m = 0; m < 4; ++m)
#pragma unroll
                for (int n = 0; n < 2; ++n) acc[a][b][m][n] = (f32x4){0.f, 0.f, 0.f, 0.f};
    bf16x8 At[4][2], B0[2][2], B1[2][2];
    const char* cA = (const char*)g.A + (size_t)cur.pm * tstep; const char* cB = (const char*)g.Bt + (size_t)cur.pn * tstep;
    S.a_ready(cur);
    if constexpr (SP2) {
        PG8_STAGE(PG8_SB(0, 0), cB, voffB); PG8_STAGE(PG8_SB(0, 1), cB + hstep, voffB); PG8_STAGE(PG8_SA(0, 0), cA, voffA); PG8_STAGE(PG8_SA(0, 1), cA + hstep, voffA);
        if (wr == 1) PG8_BAR;
        PG8_WAIT_V(2); PG8_BAR;
        PG8_STAGE(PG8_SB(1, 0), cB + kstep, voffB); PG8_STAGE(PG8_SA(1, 0), cA + kstep, voffA); PG8_STAGE(PG8_SB(1, 1), cB + hstep + kstep, voffB);
        PG8_WAIT_V(6); PG8_BAR;
    } else {
        PG8_STAGE(PG8_SB(0, 0), cB, voffB); PG8_STAGE(PG8_SA(0, 0), cA, voffA); PG8_STAGE(PG8_SB(0, 1), cB + hstep, voffB); PG8_STAGE(PG8_SA(0, 1), cA + hstep, voffA);
        if (wr == 1) PG8_BAR;
        PG8_WAIT_V(4); PG8_BAR;
        PG8_STAGE(PG8_SB(1, 0), cB + kstep, voffB); PG8_STAGE(PG8_SA(1, 0), cA + kstep, voffA); PG8_STAGE(PG8_SB(1, 1), cB + hstep + kstep, voffB);
        PG8_WAIT_V(6); PG8_BAR;
    }
    for (;;) {
        const bool has_next = S.next(ui + 1, nxt);
        const char* nA = has_next ? (const char*)g.A + (size_t)nxt.pm * tstep : cA; const char* nB = has_next ? (const char*)g.Bt + (size_t)nxt.pn * tstep : cB;
        for (int t = 0; t < nt; t += 2) {
            const bool last = (t == nt - 2);
            const char* a1 = cA + (size_t)(t + 1) * kstep;
            const char* a2 = last ? nA : cA + (size_t)(t + 2) * kstep; const char* b2 = last ? nB : cB + (size_t)(t + 2) * kstep;
            const char* a3 = a2 + kstep; const char* b3 = b2 + kstep;
            if (last && has_next) S.a_ready(nxt);
            if constexpr (SP2) {
            PG8_LDB(B0, 0, 0); PG8_LDB(B1, 0, 1); PG8_SCHED; PG8_LDA(At, 0, 0); PG8_STAGE(PG8_SA(1, 1), a1 + hstep, voffA);
            PG8_WAIT_V(8); PG8_WAIT_L(0); PG8_BAR; PG8_MMA(0, 0, At, B0); PG8_MMA(0, 1, At, B1); PG8_BAR; PG8_SCHED;
            PG8_LDA(At, 0, 1); PG8_STAGE(PG8_SB(0, 0), b2, voffB); PG8_STAGE(PG8_SB(0, 1), b2 + hstep, voffB); PG8_STAGE(PG8_SA(0, 0), a2, voffA);
            PG8_WAIT_V(8); PG8_WAIT_L(0); PG8_BAR; PG8_MMA(1, 0, At, B0); PG8_MMA(1, 1, At, B1); PG8_BAR; PG8_SCHED;
            PG8_LDB(B0, 1, 0); PG8_LDB(B1, 1, 1); PG8_SCHED; PG8_LDA(At, 1, 0); PG8_STAGE(PG8_SA(0, 1), a2 + hstep, voffA);
            PG8_WAIT_V(8); PG8_WAIT_L(0); PG8_BAR; PG8_MMA(0, 0, At, B0); PG8_MMA(0, 1, At, B1); PG8_BAR; PG8_SCHED;
            PG8_LDA(At, 1, 1); PG8_STAGE(PG8_SB(1, 0), b3, voffB); PG8_STAGE(PG8_SB(1, 1), b3 + hstep, voffB); PG8_STAGE(PG8_SA(1, 0), a3, voffA);
            PG8_WAIT_V(8); PG8_WAIT_L(0); PG8_BAR; PG8_MMA(1, 0, At, B0); PG8_MMA(1, 1, At, B1); PG8_BAR; PG8_SCHED;
            } else {
            PG8_LDB(B0, 0, 0); PG8_SCHED; PG8_LDA(At, 0, 0); PG8_STAGE(PG8_SA(1, 1), a1 + hstep, voffA);
            PG8_WAIT_L(8); PG8_BAR; PG8_WAIT_L(0); PG8_MMA(0, 0, At, B0); PG8_BAR; PG8_SCHED;
            PG8_LDB(B1, 0, 1); PG8_STAGE(PG8_SB(0, 0), b2, voffB);
            PG8_BAR; PG8_WAIT_L(0); PG8_MMA(0, 1, At, B1); PG8_BAR;
            PG8_LDA(At, 0, 1); PG8_STAGE(PG8_SA(0, 0), a2, voffA);
            PG8_BAR; PG8_WAIT_L(0); PG8_MMA(1, 0, At, B0); PG8_BAR; PG8_SCHED;
            PG8_STAGE(PG8_SB(0, 1), b2 + hstep, voffB);
            PG8_WAIT_V(6); PG8_BAR; PG8_MMA(1, 1, At, B1); PG8_BAR;
            PG8_LDB(B0, 1, 0); PG8_SCHED; PG8_LDA(At, 1, 0); PG8_STAGE(PG8_SA(0, 1), a2 + hstep, voffA);
            PG8_WAIT_L(8); PG8_BAR; PG8_WAIT_L(0); PG8_MMA(0, 0, At, B0); PG8_BAR; PG8_SCHED;
            PG8_LDB(B1, 1, 1); PG8_STAGE(PG8_SB(1, 0), b3, voffB);
            PG8_BAR; PG8_WAIT_L(0); PG8_MMA(0, 1, At, B1); PG8_BAR;
            PG8_LDA(At, 1, 1); PG8_STAGE(PG8_SA(1, 0), a3, voffA);
            PG8_BAR; PG8_WAIT_L(0); PG8_MMA(1, 0, At, B0); PG8_BAR; PG8_SCHED;
            PG8_STAGE(PG8_SB(1, 1), b3 + hstep, voffB);
            PG8_WAIT_V(6); PG8_BAR; PG8_MMA(1, 1, At, B1); PG8_BAR;
            }
        }
        if constexpr (ALIGN_EPI) { if (wr == 0) PG8_BAR; }
        if constexpr (!Epi::AFTER_DRAIN) { E(acc, cur, wr, wc, fr, fq); S.done(cur); }
        if (!has_next) break;
#pragma unroll
        for (int a = 0; a < 2; ++a)
#pragma unroll
            for (int b = 0; b < 2; ++b)
#pragma unroll
                for (int m = 0; m < 4; ++m)
#pragma unroll
                    for (int n = 0; n < 2; ++n) acc[a][b][m][n] = (f32x4){0.f, 0.f, 0.f, 0.f};
        cur = nxt; cA = nA; cB = nB; ++ui;
        if constexpr (ALIGN_EPI) { if (wr == 1) PG8_BAR; }
    }
    PG8_WAIT_V(0);
    if constexpr (!ALIGN_EPI) { if (wr == 0) PG8_BAR; }
    PG8_BAR;
    if constexpr (Epi::AFTER_DRAIN) { E.fused(acc, cur, wr, wc, fr, fq, lds, wid, lane); S.done(cur); }
#undef PG8_SA
#undef PG8_SB
#undef PG8_STAGE
#undef PG8_LDA
#undef PG8_LDB
#undef PG8_MMA
#undef PG8_WAIT_V
#undef PG8_WAIT_L
#undef PG8_BAR
#undef PG8_SCHED
}
}

using pg8::bf16_t; using pg8::bf16x8; using pg8::f32x4; using pg8::u32x4; using pg8::Unit; using pg8::cvt_pk_bf16;
#define LAS __attribute__((address_space(3)))
typedef short s16x4 __attribute__((ext_vector_type(4)));

constexpr int NT = 8192;
constexpr int SEQ = 2048, DM = 2048, DFF = 8192, INW = 6672, INW_PAD = 6912;
constexpr int CONVD = 1536;
constexpr float EPS = 1e-6f;
constexpr size_t MiB = 1u << 20;
constexpr size_t WS_HBUF = 0;
constexpr size_t WS_Q = 32 * MiB, WS_K = 48 * MiB, WS_V = 64 * MiB, WS_G = 80 * MiB, WS_Z = 96 * MiB;
constexpr int XB_ST_OFF = 139264 + 128;
constexpr size_t WS_U = 0;
constexpr size_t WS_WUP = 128 * MiB;
constexpr size_t OUT_WIN = 0, OUT_SS = 0, OUT_SR = 16 * MiB;
constexpr size_t WS_WDN = 160 * MiB;
constexpr size_t WS_XBC = 192 * MiB;
constexpr size_t WS_DT = 216 * MiB;
constexpr size_t WS_ACS = 217 * MiB;
constexpr size_t WS_H2W = 192 * MiB;
constexpr size_t WS_XC = 224 * MiB;
constexpr size_t WS_SSQ2 = 224 * MiB;
constexpr size_t WS_SSQ3 = 225 * MiB;
constexpr size_t WS_WOUT = 112 * MiB;
constexpr size_t WS_CTL = 248 * MiB;
constexpr int LDS_BYTES = 139264 + 256;
#ifndef REP0
#define REP0 1
#endif
#ifndef REP2
#define REP2 1
#endif
#ifndef REP4
#define REP4 1
#endif
#ifndef REP5
#define REP5 1
#endif
#ifndef REP6
#define REP6 1
#endif

struct Args {
    const float* x; const float* norm_mix_w; const float* w_in; const float* ret_norm_w; const float* conv_w; const float* conv_b;
    const float* dt_bias; const float* a_log; const float* d_skip; const float* ssd_norm_w; const float* w_out; const float* norm_mlp_w;
    const float* w_up; const float* w_down; const float* norm_final_w;
    float* out; unsigned char* ws;
};

__device__ __forceinline__ float bf2f(unsigned short b) { return __builtin_bit_cast(float, (unsigned)b << 16); }
__device__ __forceinline__ float bflo(unsigned w) { return __builtin_bit_cast(float, w << 16); }
__device__ __forceinline__ float bfhi(unsigned w) { return __builtin_bit_cast(float, w & 0xffff0000u); }
__device__ __forceinline__ unsigned short f2bf(float f) { return (unsigned short)(cvt_pk_bf16(f, 0.f) & 0xffffu); }
__device__ __forceinline__ float silu_f(float x) { return x / (1.f + __expf(-x)); }
__device__ __forceinline__ float wave_sum(float v) {
#pragma unroll
    for (int o = 1; o < 64; o <<= 1) v += __shfl_xor(v, o);
    return v;
}
__device__ __forceinline__ f32x4 mfma16(bf16x8 a, bf16x8 b, f32x4 c) { return __builtin_amdgcn_mfma_f32_16x16x32_bf16(a, b, c, 0, 0, 0); }
__device__ __forceinline__ bf16x8 frag_row(const LAS unsigned char* base, int pitchB, int r0, int c0, int lane) {
    return *(const LAS bf16x8*)(base + (r0 + (lane & 15)) * pitchB + (c0 + 8 * (lane >> 4)) * 2);
}
__device__ __forceinline__ bf16x8 frag_tr(const LAS unsigned char* base, int pitchB, int k0, int c0, int lane) {
    const int g = lane >> 4, q = (lane & 15) >> 2, p = lane & 3;
    const LAS unsigned char* a = base + (k0 + 8 * g + q) * pitchB + (c0 + 4 * p) * 2;
    const s16x4 lo = __builtin_amdgcn_ds_read_tr16_b64_v4i16((LAS s16x4*)a);
    const s16x4 hi = __builtin_amdgcn_ds_read_tr16_b64_v4i16((LAS s16x4*)(a + 4 * pitchB));
    bf16x8 r; r[0] = lo[0]; r[1] = lo[1]; r[2] = lo[2]; r[3] = lo[3]; r[4] = hi[0]; r[5] = hi[1]; r[6] = hi[2]; r[7] = hi[3];
    return r;
}
__device__ __forceinline__ bf16x8 gfrag_row(const bf16_t* base, int ld, int r0, int c0, int lane) {
    return *(const bf16x8*)(base + (size_t)(r0 + (lane & 15)) * ld + c0 + 8 * (lane >> 4));
}
#define WAVE_LDS_SYNC() asm volatile("s_waitcnt lgkmcnt(0)" ::: "memory")

struct EpiInProj {
    static constexpr bool PERM = true, AFTER_DRAIN = false;
    bf16_t *qkvgz, *xbc; float* dt; const float* dt_bias;
    __device__ __forceinline__ void operator()(const f32x4 (&acc)[2][2][4][2], const Unit& u, int wr, int wc, int fr, int fq) const {
        const int row0 = u.pm * 256 + wr * 64 + fr, pn = u.pn, cw = wc * 32 + 8 * fq;
        if (pn < 8) {
            bf16_t* base = qkvgz + (size_t)(pn >> 2) * (size_t)(NT * 1024); const float sc = (pn < 4) ? 1.f : 0.0625f; const int hc = (pn & 3) * 256;
            float invf[2][4];
#pragma unroll
            for (int n = 0; n < 2; ++n)
#pragma unroll
                for (int j = 0; j < 4; ++j) invf[n][j] = exp2f(-(float)(cw + 4 * n + j) * (13.287712379549449f / 128.f)) * 0.15915494309189535f;
#pragma unroll
            for (int ai = 0; ai < 2; ++ai)
#pragma unroll
                for (int m = 0; m < 4; ++m) {
                    const int row = row0 + ai * 128 + m * 16; const float pos = (float)(row & (SEQ - 1));
                    float o1[8], o2[8];
#pragma unroll
                    for (int n = 0; n < 2; ++n)
#pragma unroll
                        for (int j = 0; j < 4; ++j) {
                            float rev = pos * invf[n][j]; rev -= floorf(rev);
                            const float s = __builtin_amdgcn_sinf(rev), c = __builtin_amdgcn_cosf(rev);
                            const float x1 = acc[ai][0][m][n][j], x2 = acc[ai][1][m][n][j];
                            o1[n * 4 + j] = (x1 * c - x2 * s) * sc; o2[n * 4 + j] = (x1 * s + x2 * c) * sc;
                        }
                    u32x4 w1, w2;
                    w1.x = cvt_pk_bf16(o1[0], o1[1]); w1.y = cvt_pk_bf16(o1[2], o1[3]); w1.z = cvt_pk_bf16(o1[4], o1[5]); w1.w = cvt_pk_bf16(o1[6], o1[7]);
                    w2.x = cvt_pk_bf16(o2[0], o2[1]); w2.y = cvt_pk_bf16(o2[2], o2[3]); w2.z = cvt_pk_bf16(o2[4], o2[5]); w2.w = cvt_pk_bf16(o2[6], o2[7]);
                    bf16_t* rp = base + (size_t)row * 1024 + hc + cw;
                    *(u32x4*)rp = w1; *(u32x4*)(rp + 128) = w2;
                }
        } else if (pn < 26) {
            bf16_t* base; int ld, hc; bool act;
            if (pn < 20) { base = qkvgz + (size_t)(pn >> 2) * (size_t)(NT * 1024); act = (pn >= 12); ld = 1024; hc = (pn & 3) * 256; }
            else { base = xbc; act = false; ld = CONVD; hc = (pn - 20) * 256; }
#pragma unroll
            for (int ai = 0; ai < 2; ++ai)
#pragma unroll
                for (int m = 0; m < 4; ++m) {
                    bf16_t* rp = base + (size_t)(row0 + ai * 128 + m * 16) * ld + hc + cw;
#pragma unroll
                    for (int bj = 0; bj < 2; ++bj) {
                        f32x4 v0 = acc[ai][bj][m][0], v1 = acc[ai][bj][m][1];
                        if (act) {
#pragma unroll
                            for (int j = 0; j < 4; ++j) { v0[j] = silu_f(v0[j]); v1[j] = silu_f(v1[j]); }
                        }
                        u32x4 w; w.x = cvt_pk_bf16(v0[0], v0[1]); w.y = cvt_pk_bf16(v0[2], v0[3]); w.z = cvt_pk_bf16(v1[0], v1[1]); w.w = cvt_pk_bf16(v1[2], v1[3]);
                        *(u32x4*)(rp + bj * 128) = w;
                    }
                }
        } else {
            if (wc == 0 && fq < 2) {
#pragma unroll
                for (int ai = 0; ai < 2; ++ai)
#pragma unroll
                    for (int m = 0; m < 4; ++m) {
                        const int row = row0 + ai * 128 + m * 16;
#pragma unroll
                        for (int n = 0; n < 2; ++n) {
                            f32x4 o;
#pragma unroll
                            for (int j = 0; j < 4; ++j) { const float xv = acc[ai][0][m][n][j] + dt_bias[8 * fq + 4 * n + j]; o[j] = (xv > 20.f) ? xv : log1pf(__expf(xv)); }
                            *(f32x4*)(dt + (size_t)row * 16 + 8 * fq + 4 * n) = o;
                        }
                    }
            }
        }
    }
};
struct EpiOutProj {
    static constexpr bool PERM = true, AFTER_DRAIN = false;
    const float* x; float* h2; bf16_t* h2w; const float* nw; float* ssq;
    __device__ __forceinline__ void operator()(const f32x4 (&acc)[2][2][4][2], const Unit& u, int wr, int wc, int fr, int fq) const {
        const int row0 = u.pm * 256 + wr * 64 + fr, c0 = u.pn * 256 + wc * 32 + 8 * fq;
#pragma unroll
        for (int ai = 0; ai < 2; ++ai)
#pragma unroll
            for (int m = 0; m < 4; ++m) {
                const int row = row0 + ai * 128 + m * 16; float ss = 0.f;
#pragma unroll
                for (int bj = 0; bj < 2; ++bj) {
                    const size_t off = (size_t)row * DM + c0 + bj * 128;
                    const f32x4 x0 = *(const f32x4*)(x + off), x1 = *(const f32x4*)(x + off + 4);
                    const f32x4 v0 = acc[ai][bj][m][0] + x0, v1 = acc[ai][bj][m][1] + x1;
                    *(f32x4*)(h2 + off) = v0; *(f32x4*)(h2 + off + 4) = v1;
                    ss += (v0[0] * v0[0] + v0[1] * v0[1]) + (v0[2] * v0[2] + v0[3] * v0[3]) + (v1[0] * v1[0] + v1[1] * v1[1]) + (v1[2] * v1[2] + v1[3] * v1[3]);
                    const f32x4 w0 = *(const f32x4*)(nw + c0 + bj * 128), w1 = *(const f32x4*)(nw + c0 + bj * 128 + 4);
                    u32x4 w; w.x = cvt_pk_bf16(v0[0] * w0[0], v0[1] * w0[1]); w.y = cvt_pk_bf16(v0[2] * w0[2], v0[3] * w0[3]);
                    w.z = cvt_pk_bf16(v1[0] * w1[0], v1[1] * w1[1]); w.w = cvt_pk_bf16(v1[2] * w1[2], v1[3] * w1[3]);
                    *(u32x4*)(h2w + off) = w;
                }
                ss += __shfl_xor(ss, 16); ss += __shfl_xor(ss, 32);
                if (fq == 0) ssq[(size_t)row * 32 + u.pn * 4 + wc] = ss;
            }
    }
};
__device__ __forceinline__ float row_rstd(const float* ssq, int row) {
    const f32x4* p = (const f32x4*)(ssq + (size_t)row * 32); float s = 0.f;
#pragma unroll
    for (int i = 0; i < 8; ++i) { const f32x4 t = p[i]; s += (t[0] + t[1]) + (t[2] + t[3]); }
    return rsqrtf(s * (1.f / DM) + EPS);
}
struct EpiUp {
    static constexpr bool PERM = true, AFTER_DRAIN = false;
    bf16_t* U; const float* ssq;
    __device__ __forceinline__ void operator()(const f32x4 (&acc)[2][2][4][2], const Unit& u, int wr, int wc, int fr, int fq) const {
        const int row0 = u.pm * 256 + wr * 64 + fr, c0 = u.pn * 256 + wc * 32 + 8 * fq;
#pragma unroll
        for (int ai = 0; ai < 2; ++ai)
#pragma unroll
            for (int m = 0; m < 4; ++m) {
                const int row = row0 + ai * 128 + m * 16; const float rs = row_rstd(ssq, row);
#pragma unroll
                for (int bj = 0; bj < 2; ++bj) {
                    f32x4 v0 = acc[ai][bj][m][0] * rs, v1 = acc[ai][bj][m][1] * rs;
#pragma unroll
                    for (int j = 0; j < 4; ++j) { const float a = fmaxf(v0[j], 0.f), b = fmaxf(v1[j], 0.f); v0[j] = a * a; v1[j] = b * b; }
                    u32x4 w; w.x = cvt_pk_bf16(v0[0], v0[1]); w.y = cvt_pk_bf16(v0[2], v0[3]); w.z = cvt_pk_bf16(v1[0], v1[1]); w.w = cvt_pk_bf16(v1[2], v1[3]);
                    *(u32x4*)(U + (size_t)row * DFF + c0 + bj * 128) = w;
                }
            }
    }
};
struct EpiDown {
    static constexpr bool PERM = true, AFTER_DRAIN = false;
    float* h; float* ssq;
    __device__ __forceinline__ void operator()(const f32x4 (&acc)[2][2][4][2], const Unit& u, int wr, int wc, int fr, int fq) const {
        const int row0 = u.pm * 256 + wr * 64 + fr, c0 = u.pn * 256 + wc * 32 + 8 * fq;
#pragma unroll
        for (int ai = 0; ai < 2; ++ai)
#pragma unroll
            for (int m = 0; m < 4; ++m) {
                const int row = row0 + ai * 128 + m * 16; float ss = 0.f;
#pragma unroll
                for (int bj = 0; bj < 2; ++bj) {
                    const size_t off = (size_t)row * DM + c0 + bj * 128;
                    const f32x4 x0 = *(const f32x4*)(h + off), x1 = *(const f32x4*)(h + off + 4);
                    const f32x4 v0 = acc[ai][bj][m][0] + x0, v1 = acc[ai][bj][m][1] + x1;
                    *(f32x4*)(h + off) = v0; *(f32x4*)(h + off + 4) = v1;
                    ss += (v0[0] * v0[0] + v0[1] * v0[1]) + (v0[2] * v0[2] + v0[3] * v0[3]) + (v1[0] * v1[0] + v1[1] * v1[1]) + (v1[2] * v1[2] + v1[3] * v1[3]);
                }
                ss += __shfl_xor(ss, 16); ss += __shfl_xor(ss, 32);
                if (fq == 0) ssq[(size_t)row * 32 + u.pn * 4 + wc] = ss;
            }
    }
};

__device__ __forceinline__ void transpose_item(const float* W, int K, int N, bf16_t* WT, LAS float* scr, int item, int lane) {
    const int nblk = (N + 63) >> 6, kb = item / nblk, nb = item - kb * nblk, k0 = kb * 64, n0 = nb * 64;
    const int n4 = (lane & 15) * 4, kr = lane >> 4;
#pragma unroll 4
    for (int i = 0; i < 16; ++i) {
        const int kk = i * 4 + kr;
        f32x4 v = (f32x4){0.f, 0.f, 0.f, 0.f};
        if (n0 + n4 < N) v = *(const f32x4*)(W + (size_t)(k0 + kk) * N + n0 + n4);
        LAS float* s = scr + kk * 65 + n4; s[0] = v[0]; s[1] = v[1]; s[2] = v[2]; s[3] = v[3];
    }
    WAVE_LDS_SYNC();
    const int c = lane & 7;
#pragma unroll
    for (int j = 0; j < 8; ++j) {
        const int n = j * 8 + (lane >> 3); const LAS float* s = scr + (8 * c) * 65 + n;
        u32x4 o; o.x = cvt_pk_bf16(s[0], s[65]); o.y = cvt_pk_bf16(s[2 * 65], s[3 * 65]); o.z = cvt_pk_bf16(s[4 * 65], s[5 * 65]); o.w = cvt_pk_bf16(s[6 * 65], s[7 * 65]);
        if (n0 + n < N) *(u32x4*)(WT + (size_t)(n0 + n) * K + k0 + 8 * c) = o;
    }
    WAVE_LDS_SYNC();
}
__device__ __forceinline__ void transpose_weight(const float* W, int K, int N, bf16_t* WT, LAS unsigned char* lds, int gw, int ngw, int wave, int lane) {
    LAS float* scr = (LAS float*)(lds + wave * (64 * 65 * 4));
    const int nitems = (K >> 6) * ((N + 63) >> 6);
    for (int it = gw; it < nitems; it += ngw) transpose_item(W, K, N, WT, scr, it, lane);
}
__device__ __forceinline__ void rms_row_bf16(const float* xrow, const float* w, bf16_t* orow, int lane) {
    const f32x4* xr = (const f32x4*)xrow + lane; f32x4 v[8]; float s = 0.f;
#pragma unroll
    for (int j = 0; j < 8; ++j) { v[j] = xr[64 * j]; s += (v[j][0] * v[j][0] + v[j][1] * v[j][1]) + (v[j][2] * v[j][2] + v[j][3] * v[j][3]); }
    const float rs = rsqrtf(wave_sum(s) * (1.f / DM) + EPS);
    const f32x4* wr = (const f32x4*)w + lane;
    unsigned long long* o8 = (unsigned long long*)orow + lane;
#pragma unroll
    for (int j = 0; j < 8; ++j) { const f32x4 ww = wr[64 * j];
        o8[64 * j] = (unsigned long long)cvt_pk_bf16(v[j][0] * rs * ww[0], v[j][1] * rs * ww[1]) | ((unsigned long long)cvt_pk_bf16(v[j][2] * rs * ww[2], v[j][3] * rs * ww[3]) << 32); }
}

constexpr int P264 = 528, P136 = 272;
constexpr int T264 = 128 * P264, T136 = 128 * P136;

__device__ __forceinline__ float ret_log2_gamma(int h) { return log2f(1.f - exp2f(-5.f - (float)h)); }

__device__ __forceinline__ void conv_silu8(const bf16_t* XBC, const float* cw, const float* cb, int b, int s, int col, float (&o)[8]) {
    { const f32x4 b0 = *(const f32x4*)(cb + col), b1 = *(const f32x4*)(cb + col + 4);
      o[0] = b0[0]; o[1] = b0[1]; o[2] = b0[2]; o[3] = b0[3]; o[4] = b1[0]; o[5] = b1[1]; o[6] = b1[2]; o[7] = b1[3]; }
#pragma unroll
    for (int j = 0; j < 4; ++j) {
        const int sj = s - 3 + j;
        if (sj >= 0) {
            const u32x4 r = *(const u32x4*)(XBC + (size_t)(b * SEQ + sj) * CONVD + col);
            const f32x4 w0 = *(const f32x4*)(cw + j * CONVD + col), w1 = *(const f32x4*)(cw + j * CONVD + col + 4);
            o[0] += w0[0] * bflo(r.x); o[1] += w0[1] * bfhi(r.x); o[2] += w0[2] * bflo(r.y); o[3] += w0[3] * bfhi(r.y);
            o[4] += w1[0] * bflo(r.z); o[5] += w1[1] * bfhi(r.z); o[6] += w1[2] * bflo(r.w); o[7] += w1[3] * bfhi(r.w);
        }
    }
#pragma unroll
    for (int i = 0; i < 8; ++i) o[i] = silu_f(o[i]);
}
__device__ __forceinline__ u32x4 pack8(const float (&o)[8]) {
    u32x4 w; w.x = cvt_pk_bf16(o[0], o[1]); w.y = cvt_pk_bf16(o[2], o[3]); w.z = cvt_pk_bf16(o[4], o[5]); w.w = cvt_pk_bf16(o[6], o[7]); return w;
}

__device__ __forceinline__ void p2_ret_item(const Args& A, LAS unsigned char* lds, int b, int n, int h, int tid, int wave, int lane) {
    const bf16_t* Kg = (const bf16_t*)(A.ws + WS_K); const bf16_t* Vg = (const bf16_t*)(A.ws + WS_V); bf16_t* SR = (bf16_t*)((unsigned char*)A.out + OUT_SR);
    LAS unsigned char* vs = lds; LAS unsigned char* ks = lds + T264;
    const int row0 = b * SEQ + n * 128; const float lg = ret_log2_gamma(h);
    for (int i = tid; i < 4096; i += 512) {
        const int r = i >> 5, c = i & 31; const size_t go = (size_t)(row0 + r) * 1024 + h * 256 + c * 8;
        const u32x4 kk = *(const u32x4*)(Kg + go); *(LAS u32x4*)(ks + r * P264 + c * 16) = kk;
        const u32x4 vv = *(const u32x4*)(Vg + go); const float sc = exp2f((float)(127 - r) * lg);
        u32x4 w; w.x = cvt_pk_bf16(bflo(vv.x) * sc, bfhi(vv.x) * sc); w.y = cvt_pk_bf16(bflo(vv.y) * sc, bfhi(vv.y) * sc);
        w.z = cvt_pk_bf16(bflo(vv.z) * sc, bfhi(vv.z) * sc); w.w = cvt_pk_bf16(bflo(vv.w) * sc, bfhi(vv.w) * sc);
        *(LAS u32x4*)(vs + r * P264 + c * 16) = w;
    }
    __syncthreads();
    const int eq = wave >> 1, dh = wave & 1;
    bf16_t* So = SR + (size_t)((b * 16 + n) * 4 + h) * 65536;
#pragma unroll 1
    for (int dq = 0; dq < 2; ++dq) {
        const int d0 = dh * 128 + dq * 64;
        f32x4 acc[4][4];
#pragma unroll
        for (int i = 0; i < 4; ++i)
#pragma unroll
            for (int j = 0; j < 4; ++j) acc[i][j] = (f32x4){0.f, 0.f, 0.f, 0.f};
#pragma unroll
        for (int kt = 0; kt < 4; ++kt) {
            bf16x8 a[4], bb[4];
#pragma unroll
            for (int i = 0; i < 4; ++i) { a[i] = frag_tr(vs, P264, kt * 32, eq * 64 + i * 16, lane); bb[i] = frag_tr(ks, P264, kt * 32, d0 + i * 16, lane); }
#pragma unroll
            for (int i = 0; i < 4; ++i)
#pragma unroll
                for (int j = 0; j < 4; ++j) acc[i][j] = mfma16(a[i], bb[j], acc[i][j]);
        }
#pragma unroll
        for (int i = 0; i < 4; ++i)
#pragma unroll
            for (int j = 0; j < 4; ++j)
#pragma unroll
                for (int jj = 0; jj < 4; ++jj) {
                    const int e = eq * 64 + i * 16 + 4 * (lane >> 4) + jj, d = d0 + j * 16 + (lane & 15);
                    So[e * 256 + d] = f2bf(acc[i][j][jj]);
                }
    }
    __syncthreads();
}

__device__ __forceinline__ void p2_ssd_item(const Args& A, LAS unsigned char* lds, int b, int n, int hq, int tid, int wave, int lane) {
    const bf16_t* XBC = (const bf16_t*)(A.ws + WS_XBC); bf16_t* XC = (bf16_t*)(A.ws + WS_XC); bf16_t* SS = (bf16_t*)((unsigned char*)A.out + OUT_SS);
    const float* DT = (const float*)(A.ws + WS_DT); float* ACS = (float*)(A.ws + WS_ACS);
    LAS unsigned char* xsw = lds; LAS unsigned char* Bs = lds + T264;
    LAS float* dts = (LAS float*)(lds + T264 + T136); LAS float* acl = dts + 512; LAS float* wl = acl + 512;
    const int g = hq >> 1, row0 = b * SEQ + n * 128;
    { const int r = tid >> 2, e = tid & 3; dts[tid] = DT[(size_t)(row0 + r) * 16 + hq * 4 + e]; }
    __syncthreads();
    if (tid < 4) { const float a = -__expf(A.a_log[hq * 4 + tid]); float s = 0.f;
        for (int r = 0; r < 128; ++r) { s += dts[r * 4 + tid] * a; acl[r * 4 + tid] = s; } }
    __syncthreads();
    { const int r = tid >> 2, e = tid & 3; const float ac = acl[tid], tot = acl[127 * 4 + e];
      wl[tid] = dts[tid] * __expf(tot - ac); ACS[(size_t)(row0 + r) * 16 + hq * 4 + e] = ac; }
    __syncthreads();
    for (int i = tid; i < 4096; i += 512) {
        const int r = i >> 5, c = i & 31, col = hq * 256 + c * 8; float o[8];
        conv_silu8(XBC, A.conv_w, A.conv_b, b, n * 128 + r, col, o);
        *(u32x4*)(XC + (size_t)(row0 + r) * CONVD + col) = pack8(o);
        const float w = wl[r * 4 + (c >> 3)];
#pragma unroll
        for (int j = 0; j < 8; ++j) o[j] *= w;
        *(LAS u32x4*)(xsw + r * P264 + c * 16) = pack8(o);
    }
    for (int i = tid; i < 2048; i += 512) {
        const int r = i >> 4, c = i & 15, col = 1024 + g * 128 + c * 8; float o[8];
        conv_silu8(XBC, A.conv_w, A.conv_b, b, n * 128 + r, col, o);
        const u32x4 w = pack8(o);
        *(LAS u32x4*)(Bs + r * P136 + c * 16) = w;
        if ((hq & 1) == 0) *(u32x4*)(XC + (size_t)(row0 + r) * CONVD + col) = w;
    }
    if ((hq & 1) == 0) {
        for (int i = tid; i < 2048; i += 512) {
            const int r = i >> 4, c = i & 15, col = 1280 + g * 128 + c * 8; float o[8];
            conv_silu8(XBC, A.conv_w, A.conv_b, b, n * 128 + r, col, o);
            *(u32x4*)(XC + (size_t)(row0 + r) * CONVD + col) = pack8(o);
        }
    }
    __syncthreads();
    const int e = wave >> 1, kh = wave & 1;
    f32x4 acc[4][4];
#pragma unroll
    for (int i = 0; i < 4; ++i)
#pragma unroll
        for (int j = 0; j < 4; ++j) acc[i][j] = (f32x4){0.f, 0.f, 0.f, 0.f};
#pragma unroll
    for (int kt = 0; kt < 4; ++kt) {
        bf16x8 a[4], bb[4];
#pragma unroll
        for (int i = 0; i < 4; ++i) { a[i] = frag_tr(xsw, P264, kt * 32, e * 64 + i * 16, lane); bb[i] = frag_tr(Bs, P136, kt * 32, kh * 64 + i * 16, lane); }
#pragma unroll
        for (int i = 0; i < 4; ++i)
#pragma unroll
            for (int j = 0; j < 4; ++j) acc[i][j] = mfma16(a[i], bb[j], acc[i][j]);
    }
    bf16_t* So = SS + (size_t)((b * 16 + n) * 16 + hq * 4 + e) * 8192;
#pragma unroll
    for (int i = 0; i < 4; ++i)
#pragma unroll
        for (int j = 0; j < 4; ++j)
#pragma unroll
            for (int jj = 0; jj < 4; ++jj) {
                const int p = i * 16 + 4 * (lane >> 4) + jj, k = kh * 64 + j * 16 + (lane & 15);
                So[p * 128 + k] = f2bf(acc[i][j][jj]);
            }
    __syncthreads();
}

__device__ __forceinline__ void p3_scan(const Args& A, int gtid, int gthreads) {
    bf16_t* SR = (bf16_t*)((unsigned char*)A.out + OUT_SR); bf16_t* SS = (bf16_t*)((unsigned char*)A.out + OUT_SS); const float* ACS = (const float*)(A.ws + WS_ACS);
    for (int it = gtid; it < 131072 + 65536; it += gthreads) {
        bf16_t* base; size_t nstride; float dec[16];
        if (it < 131072) {
            const int bh = it >> 13, off = (it & 8191) * 8, b = bh >> 2, h = bh & 3;
            base = SR + (size_t)(b * 16 * 4 + h) * 65536 + off; nstride = (size_t)4 * 65536;
            const float gd = exp2f(128.f * ret_log2_gamma(h));
#pragma unroll
            for (int n = 0; n < 16; ++n) dec[n] = gd;
        } else {
            const int i2 = it - 131072, bh = i2 >> 10, off = (i2 & 1023) * 8, b = bh >> 4, h = bh & 15;
            base = SS + (size_t)(b * 16 * 16 + h) * 8192 + off; nstride = (size_t)16 * 8192;
#pragma unroll
            for (int n = 0; n < 16; ++n) dec[n] = __expf(ACS[(size_t)(b * SEQ + n * 128 + 127) * 16 + h]);
        }
        u32x4 kv[16];
#pragma unroll
        for (int n = 0; n < 16; ++n) kv[n] = *(const u32x4*)(base + n * nstride);
        float S[8];
#pragma unroll
        for (int j = 0; j < 8; ++j) S[j] = 0.f;
#pragma unroll
        for (int n = 0; n < 16; ++n) {
            *(u32x4*)(base + n * nstride) = pack8(S);
            const float d = dec[n];
            S[0] = d * S[0] + bflo(kv[n].x); S[1] = d * S[1] + bfhi(kv[n].x); S[2] = d * S[2] + bflo(kv[n].y); S[3] = d * S[3] + bfhi(kv[n].y);
            S[4] = d * S[4] + bflo(kv[n].z); S[5] = d * S[5] + bfhi(kv[n].z); S[6] = d * S[6] + bflo(kv[n].w); S[7] = d * S[7] + bfhi(kv[n].w);
        }
    }
}

__device__ __forceinline__ u32x4 mul_bf16x8(u32x4 a, u32x4 g) {
    u32x4 w; w.x = cvt_pk_bf16(bflo(a.x) * bflo(g.x), bfhi(a.x) * bfhi(g.x)); w.y = cvt_pk_bf16(bflo(a.y) * bflo(g.y), bfhi(a.y) * bfhi(g.y));
    w.z = cvt_pk_bf16(bflo(a.z) * bflo(g.z), bfhi(a.z) * bfhi(g.z)); w.w = cvt_pk_bf16(bflo(a.w) * bflo(g.w), bfhi(a.w) * bfhi(g.w)); return w;
}
__device__ __forceinline__ void p4_ret_item(const Args& A, LAS unsigned char* lds, int b, int n, int h, int tid, int wave, int lane) {
    const bf16_t* Qg = (const bf16_t*)(A.ws + WS_Q); const bf16_t* Kg = (const bf16_t*)(A.ws + WS_K); const bf16_t* Vg = (const bf16_t*)(A.ws + WS_V);
    const bf16_t* Gg = (const bf16_t*)(A.ws + WS_G); const bf16_t* SR = (const bf16_t*)((unsigned char*)A.out + OUT_SR); bf16_t* MIX = (bf16_t*)(A.ws + WS_HBUF);
    LAS unsigned char* RA = lds; LAS unsigned char* Ps = lds + T264; LAS unsigned char* RB = lds + T264 + T136;
    constexpr int PC = 144;
    const int row0 = b * SEQ + n * 128; const float lg = ret_log2_gamma(h);
    const int fq = lane >> 4, fr = lane & 15;
    const bf16_t* Sp = SR + (size_t)((b * 16 + n) * 4 + h) * 65536;
#define STAGE_ST(dst, dc) do { for (int i_ = tid; i_ < 2048; i_ += 512) { const int e_ = i_ >> 3, c_ = i_ & 7; \
        *(LAS u32x4*)((dst) + e_ * PC + c_ * 16) = *(const u32x4*)(Sp + e_ * 256 + (dc) * 64 + c_ * 8); } } while (0)
    STAGE_ST(RB, 0);
    bf16x8 qf[8];
#pragma unroll
    for (int kt = 0; kt < 8; ++kt) qf[kt] = gfrag_row(Qg + h * 256, 1024, row0 + 16 * wave, kt * 32, lane);
    f32x4 y[16];
#pragma unroll
    for (int eb = 0; eb < 16; ++eb) y[eb] = (f32x4){0.f, 0.f, 0.f, 0.f};
    __syncthreads();
#pragma unroll
    for (int dc = 0; dc < 4; ++dc) {
        LAS unsigned char* cur = (dc & 1) ? RA : RB; LAS unsigned char* nxt = (dc & 1) ? RB : RA;
        if (dc < 3) STAGE_ST(nxt, dc + 1);
#pragma unroll
        for (int ktl = 0; ktl < 2; ++ktl)
#pragma unroll
            for (int eb = 0; eb < 16; ++eb) y[eb] = mfma16(qf[dc * 2 + ktl], frag_row(cur, PC, eb * 16, ktl * 32, lane), y[eb]);
        __syncthreads();
    }
#undef STAGE_ST
#pragma unroll
    for (int jj = 0; jj < 4; ++jj) { const float qd = exp2f((float)(16 * wave + 4 * fq + jj + 1) * lg);
#pragma unroll
        for (int eb = 0; eb < 16; ++eb) y[eb][jj] *= qd; }
    for (int i = tid; i < 4096; i += 512) { const int r = i >> 5, c = i & 31;
        *(LAS u32x4*)(RA + r * P264 + c * 16) = *(const u32x4*)(Kg + (size_t)(row0 + r) * 1024 + h * 256 + c * 8); }
    __syncthreads();
#pragma unroll
    for (int ch = 0; ch < 2; ++ch) {
        f32x4 sc[4];
#pragma unroll
        for (int ci = 0; ci < 4; ++ci) {
            sc[ci] = (f32x4){0.f, 0.f, 0.f, 0.f};
#pragma unroll
            for (int kt = 0; kt < 8; ++kt) sc[ci] = mfma16(qf[kt], frag_row(RA, P264, (ch * 4 + ci) * 16, kt * 32, lane), sc[ci]);
        }
#pragma unroll
        for (int ci = 0; ci < 4; ++ci)
#pragma unroll
            for (int jj = 0; jj < 4; ++jj) {
                const int c = 16 * wave + 4 * fq + jj, m2 = (ch * 4 + ci) * 16 + fr;
                const float val = (m2 <= c) ? sc[ci][jj] * exp2f((float)(c - m2) * lg) : 0.f;
                *(LAS unsigned short*)(Ps + c * P136 + m2 * 2) = f2bf(val);
            }
        __builtin_amdgcn_sched_barrier(0);
    }
    __syncthreads();
    for (int i = tid; i < 4096; i += 512) { const int r = i >> 5, c = i & 31;
        *(LAS u32x4*)(RA + r * P264 + c * 16) = *(const u32x4*)(Vg + (size_t)(row0 + r) * 1024 + h * 256 + c * 8); }
    __syncthreads();
#pragma unroll
    for (int kt = 0; kt < 4; ++kt) {
        const bf16x8 a = frag_row(Ps, P136, 16 * wave, kt * 32, lane);
#pragma unroll
        for (int eb = 0; eb < 16; ++eb) y[eb] = mfma16(a, frag_tr(RA, P264, kt * 32, eb * 16, lane), y[eb]);
    }
    float rs[4];
#pragma unroll
    for (int jj = 0; jj < 4; ++jj) { float s = 0.f;
#pragma unroll
        for (int eb = 0; eb < 16; ++eb) s += y[eb][jj] * y[eb][jj];
        s += __shfl_xor(s, 1); s += __shfl_xor(s, 2); s += __shfl_xor(s, 4); s += __shfl_xor(s, 8);
        rs[jj] = rsqrtf(s * (1.f / 256.f) + EPS); }
    __syncthreads();
#pragma unroll
    for (int eb = 0; eb < 16; ++eb) {
        const int col = eb * 16 + fr; const float wn = A.ret_norm_w[h * 256 + col];
#pragma unroll
        for (int jj = 0; jj < 4; ++jj)
            *(LAS unsigned short*)(RA + (16 * wave + 4 * fq + jj) * P264 + col * 2) = f2bf(y[eb][jj] * rs[jj] * wn);
    }
    WAVE_LDS_SYNC();
#pragma unroll
    for (int i = 0; i < 8; ++i) {
        const int idx = i * 64 + lane, rr = 16 * wave + (idx >> 5), cc = idx & 31;
        const u32x4 o = *(const LAS u32x4*)(RA + rr * P264 + cc * 16);
        const u32x4 g = *(const u32x4*)(Gg + (size_t)(row0 + rr) * 1024 + h * 256 + cc * 8);
        *(u32x4*)(MIX + (size_t)(row0 + rr) * 2048 + h * 256 + cc * 8) = mul_bf16x8(o, g);
    }
    __syncthreads();
}

__device__ __forceinline__ void p4_ssd_item(const Args& A, LAS unsigned char* lds, int b, int n, int g, int tid, int wave, int lane) {
    const bf16_t* XC = (const bf16_t*)(A.ws + WS_XC); const bf16_t* Zg = (const bf16_t*)(A.ws + WS_Z); const bf16_t* SS = (const bf16_t*)((unsigned char*)A.out + OUT_SS);
    const float* DT = (const float*)(A.ws + WS_DT); const float* ACS = (const float*)(A.ws + WS_ACS); bf16_t* MIX = (bf16_t*)(A.ws + WS_HBUF);
    LAS unsigned char* xs = lds; LAS unsigned char* R2 = lds + T264;
    LAS float* acl = (LAS float*)(lds + T264 + T136); LAS float* dtl = acl + 1024;
    const int row0 = b * SEQ + n * 128, fq = lane >> 4, fr = lane & 15;
    for (int i = tid; i < 2048; i += 512) { const int r = i >> 4, c = i & 15;
        *(LAS u32x4*)(R2 + r * P136 + c * 16) = *(const u32x4*)(XC + (size_t)(row0 + r) * CONVD + 1024 + g * 128 + c * 8); }
    for (int i = tid; i < 1024; i += 512) { const int r = i >> 3, e = i & 7;
        acl[i] = ACS[(size_t)(row0 + r) * 16 + g * 8 + e]; dtl[i] = DT[(size_t)(row0 + r) * 16 + g * 8 + e]; }
    bf16x8 cf[4];
#pragma unroll
    for (int kt = 0; kt < 4; ++kt) cf[kt] = gfrag_row(XC + 1280 + g * 128, CONVD, row0 + 16 * wave, kt * 32, lane);
    __syncthreads();
    f32x4 cbm[8];
#pragma unroll
    for (int sb = 0; sb < 8; ++sb) {
        cbm[sb] = (f32x4){0.f, 0.f, 0.f, 0.f};
        if (sb <= wave) {
#pragma unroll
            for (int kt = 0; kt < 4; ++kt) cbm[sb] = mfma16(cf[kt], frag_row(R2, P136, sb * 16, kt * 32, lane), cbm[sb]);
        }
    }
    __syncthreads();
    float ssq[4] = {0.f, 0.f, 0.f, 0.f};
#pragma unroll 1
    for (int half = 0; half < 2; ++half) {
        if (half) __syncthreads();
        for (int i = tid; i < 4096; i += 512) { const int r = i >> 5, c = i & 31;
            *(LAS u32x4*)(xs + r * P264 + c * 16) = *(const u32x4*)(XC + (size_t)(row0 + r) * CONVD + g * 512 + half * 256 + c * 8); }
        __syncthreads();
#pragma unroll 1
        for (int e4 = 0; e4 < 4; ++e4) {
            const int e = half * 4 + e4, hh = g * 8 + e;
            f32x4 acc[4];
#pragma unroll
            for (int pb = 0; pb < 4; ++pb) acc[pb] = (f32x4){0.f, 0.f, 0.f, 0.f};
            const bf16_t* Pp = SS + (size_t)((b * 16 + n) * 16 + hh) * 8192;
#pragma unroll
            for (int kt = 0; kt < 4; ++kt)
#pragma unroll
                for (int pb = 0; pb < 4; ++pb) acc[pb] = mfma16(cf[kt], gfrag_row(Pp, 128, pb * 16, kt * 32, lane), acc[pb]);
            float al[4];
#pragma unroll
            for (int jj = 0; jj < 4; ++jj) { al[jj] = acl[(16 * wave + 4 * fq + jj) * 8 + e]; const float s = __expf(al[jj]);
#pragma unroll
                for (int pb = 0; pb < 4; ++pb) acc[pb][jj] *= s; }
            WAVE_LDS_SYNC();
#pragma unroll
            for (int sb = 0; sb < 8; ++sb) {
                const int s = sb * 16 + fr; const float as = acl[s * 8 + e], ds = dtl[s * 8 + e];
#pragma unroll
                for (int jj = 0; jj < 4; ++jj) { const int l = 16 * wave + 4 * fq + jj;
                    const float val = (s <= l) ? cbm[sb][jj] * __expf(al[jj] - as) * ds : 0.f;
                    *(LAS unsigned short*)(R2 + l * P136 + s * 2) = f2bf(val); }
            }
            WAVE_LDS_SYNC();
#pragma unroll
            for (int kt = 0; kt < 4; ++kt) {
                if (kt * 32 <= 16 * wave + 15) {
                    const bf16x8 a = frag_row(R2, P136, 16 * wave, kt * 32, lane);
#pragma unroll
                    for (int pb = 0; pb < 4; ++pb) acc[pb] = mfma16(a, frag_tr(xs, P264, kt * 32, e4 * 64 + pb * 16, lane), acc[pb]);
                }
            }
            const float dsk = A.d_skip[hh];
#pragma unroll
            for (int pb = 0; pb < 4; ++pb) {
                const int pc = e4 * 64 + pb * 16 + fr;
#pragma unroll
                for (int jj = 0; jj < 4; ++jj) { const int l = 16 * wave + 4 * fq + jj;
                    const float xv = bf2f(*(const LAS unsigned short*)(xs + l * P264 + pc * 2));
                    const float zv = bf2f(Zg[(size_t)(row0 + l) * 1024 + g * 512 + half * 256 + pc]);
                    const float yv = (acc[pb][jj] + dsk * xv) * zv;
                    ssq[jj] += yv * yv;
                    MIX[(size_t)(row0 + l) * 2048 + 1024 + g * 512 + half * 256 + pc] = f2bf(yv); }
            }
        }
    }
    asm volatile("s_waitcnt vmcnt(0)" ::: "memory");
    float rs[4];
#pragma unroll
    for (int jj = 0; jj < 4; ++jj) { float s = ssq[jj];
        s += __shfl_xor(s, 1); s += __shfl_xor(s, 2); s += __shfl_xor(s, 4); s += __shfl_xor(s, 8);
        rs[jj] = rsqrtf(s * (1.f / 512.f) + EPS); }
#pragma unroll 1
    for (int e = 0; e < 8; ++e)
#pragma unroll
        for (int pb = 0; pb < 4; ++pb) {
            const int col = g * 512 + e * 64 + pb * 16 + fr; const float wn = A.ssd_norm_w[col];
#pragma unroll
            for (int jj = 0; jj < 4; ++jj) { const size_t idx = (size_t)(row0 + 16 * wave + 4 * fq + jj) * 2048 + 1024 + col;
                MIX[idx] = f2bf(bf2f(MIX[idx]) * rs[jj] * wn); }
        }
    __syncthreads();
}

#define XB_TMO      128
#define XB_XCNT(j)  (256  + 64 * (j))
#define XB_XSUB(j)  (1280 + 64 * (j))
#define XB_XGEN(j)  (2304 + 64 * (j))
#define XB_TOP      3328
#define XB_TOPGEN   3392
#define XCD_BAR_WORDS 3456
#define XB_SPIN_CAP (1u << 18)

__device__ __forceinline__ unsigned xb_ld(unsigned* p)              { return __hip_atomic_load(p, __ATOMIC_RELAXED, __HIP_MEMORY_SCOPE_AGENT); }
__device__ __forceinline__ unsigned xb_add(unsigned* p, unsigned v) { return __hip_atomic_fetch_add(p, v, __ATOMIC_RELAXED, __HIP_MEMORY_SCOPE_AGENT); }
__device__ __forceinline__ unsigned xb_xcc_id() { return (unsigned)__builtin_amdgcn_s_getreg((3 << 11) | 20) & 0xFu; }
#define XB_SPIN(cond, bar) do { unsigned _sp = 0; while (cond) { __builtin_amdgcn_s_sleep(1); \
    if ((++_sp & 255u) == 0u) { if (xb_ld(&(bar)[XB_TMO])) break; if (_sp > XB_SPIN_CAP) { atomicAdd(&(bar)[XB_TMO], 1u); break; } } } } while (0)

struct XcdBarrier {
    unsigned* bar; unsigned x;
    volatile LAS unsigned* st;
};

__device__ __forceinline__ XcdBarrier xcd_barrier_post(unsigned* bar, volatile LAS unsigned* st) {
    XcdBarrier b; b.bar = bar; b.x = xb_xcc_id(); b.st = st;
    if (threadIdx.x == 0) (void)xb_add(&bar[XB_XCNT(b.x)], 1u);
    return b;
}
__device__ __forceinline__ void xcd_barrier_complete(unsigned* bar, unsigned x, unsigned& nloc, unsigned& nx) {
    const unsigned G = gridDim.x * gridDim.y * gridDim.z;
    unsigned sum, cnt, mine, sp = 0u;
    for (;;) {
        sum = 0u; cnt = 0u; mine = 0u;
#pragma unroll
        for (unsigned j = 0; j < 16; ++j) { const unsigned c = xb_ld(&bar[XB_XCNT(j)]); sum += c; cnt += (c > 0u) ? 1u : 0u; mine = (j == x) ? c : mine; }
        if (sum == G) break;
        __builtin_amdgcn_s_sleep(1);
        if ((++sp & 255u) == 0u) { if (xb_ld(&bar[XB_TMO])) break; if (sp > XB_SPIN_CAP) { atomicAdd(&bar[XB_TMO], 1u); break; } }
    }
    nloc = mine > 0u ? mine : 1u; nx = cnt > 0u ? cnt : 1u;
}

__device__ __forceinline__ void xcd_barrier(const XcdBarrier& b) {
    asm volatile("s_waitcnt vmcnt(0)" ::: "memory");
    __syncthreads();
    if (threadIdx.x == 0) {
        unsigned* bar = b.bar;
        __builtin_amdgcn_s_waitcnt(0);
        unsigned nloc = b.st[0], nx = b.st[1];
        if (nloc == 0u) { xcd_barrier_complete(bar, b.x, nloc, nx); b.st[0] = nloc; b.st[1] = nx; }
        const unsigned old = xb_add(&bar[XB_XSUB(b.x)], 1u);
        const unsigned gen = old / nloc;
        if (old + 1u == (gen + 1u) * nloc) {
            __builtin_amdgcn_fence(__ATOMIC_RELEASE, "agent");
            asm volatile("s_waitcnt vmcnt(0)" ::: "memory");
            const unsigned og = xb_add(&bar[XB_TOP], 1u);
            const unsigned tg = og / nx;
            if (og + 1u == (tg + 1u) * nx) xb_add(&bar[XB_TOPGEN], 1u);
            else XB_SPIN(xb_ld(&bar[XB_TOPGEN]) == tg, bar);
            __builtin_amdgcn_fence(__ATOMIC_ACQUIRE, "agent");
            xb_add(&bar[XB_XGEN(b.x)], 1u);
            asm volatile("s_waitcnt vmcnt(0)" ::: "memory");
        } else {
            XB_SPIN(xb_ld(&bar[XB_XGEN(b.x)]) == gen, bar);
            __builtin_amdgcn_fence(__ATOMIC_ACQUIRE, "agent");
            asm volatile("s_waitcnt vmcnt(0)" ::: "memory");
        }
    }
    __syncthreads();
}


__global__ void __launch_bounds__(512, 2) hymba_fwd(Args A) {
    extern __shared__ __attribute__((aligned(16))) unsigned char lds_raw[];
    LAS unsigned char* lds = (LAS unsigned char*)lds_raw;
    cg::grid_group grid = cg::this_grid();
    { volatile LAS unsigned* st = (volatile LAS unsigned*)(lds + XB_ST_OFF); if (threadIdx.x < 2) st[threadIdx.x] = 0u; }
    __syncthreads();
    XcdBarrier xbar = xcd_barrier_post((unsigned*)(A.ws + WS_CTL), (volatile LAS unsigned*)(lds + XB_ST_OFF));
    grid.sync();
#define GRID_SYNC() xcd_barrier(xbar)
#define PHASE_IDS() int tid = threadIdx.x; asm volatile("" : "+v"(tid)); const int lane = tid & 63, wave = __builtin_amdgcn_readfirstlane(tid >> 6); const int gw = bx * 8 + wave, ngw = G * 8; (void)gw; (void)ngw; (void)lane
    const int G = gridDim.x, bx = blockIdx.x;
    unsigned char* ws = A.ws;

#ifndef SK0
    for (int rep_ = 0; rep_ < REP0; ++rep_) { PHASE_IDS();
    transpose_weight(A.w_in, DM, INW, (bf16_t*)((unsigned char*)A.out + OUT_WIN), lds, gw, ngw, wave, lane);
    transpose_weight(A.w_out, DM, DM, (bf16_t*)(ws + WS_WOUT), lds, gw, ngw, wave, lane);
    for (int m = gw; m < NT; m += ngw) rms_row_bf16(A.x + (size_t)m * DM, A.norm_mix_w, (bf16_t*)(ws + WS_HBUF) + (size_t)m * DM, lane);
    }
#endif
    GRID_SYNC();

#ifndef SK1
    {
        pg8::Gemm g{(const bf16_t*)(ws + WS_HBUF), (const bf16_t*)((unsigned char*)A.out + OUT_WIN), NT, INW_PAD, DM}; pg8::StaticOrder S; S.init(NT, INW_PAD, G, bx);
        EpiInProj E{(bf16_t*)(ws + WS_Q), (bf16_t*)(ws + WS_XBC), (float*)(ws + WS_DT), A.dt_bias};
        pg8::gemm_phase<EpiInProj, pg8::StaticOrder, true, true>(lds, g, S, E);
    }
    {
        PHASE_IDS();
        const int nwg1 = (NT / 256) * (INW_PAD / 256), full = nwg1 % G, nidle = (full == 0) ? G : G - full;
        const int ib = (full == 0) ? bx : bx - full;
        if (ib >= 0) {
            __syncthreads();
            transpose_weight(A.w_up, DM, DFF, (bf16_t*)(ws + WS_WUP), lds, ib * 8 + wave, nidle * 8, wave, lane);
            transpose_weight(A.w_down, DFF, DM, (bf16_t*)(ws + WS_WDN), lds, ib * 8 + wave, nidle * 8, wave, lane);
        }
    }
#endif
    GRID_SYNC();

#ifndef SK2
    for (int rep_ = 0; rep_ < REP2; ++rep_) { PHASE_IDS();
    for (int it = bx; it < 512; it += G) {
        if (it < 256) p2_ssd_item(A, lds, it >> 6, (it >> 2) & 15, it & 3, tid, wave, lane);
        else { const int j = it - 256; p2_ret_item(A, lds, j >> 6, (j >> 2) & 15, j & 3, tid, wave, lane); }
    }
    }
#endif
    GRID_SYNC();

#ifndef SK3
    { PHASE_IDS(); p3_scan(A, bx * 512 + tid, G * 512); }
#endif
    GRID_SYNC();

#ifndef SK4
    {
        const int half = G >> 1;
        if (bx < half || half == 0) { PHASE_IDS();
            for (int it = bx; it < 128; it += (half ? half : 1)) p4_ssd_item(A, lds, it >> 5, (it >> 1) & 15, it & 1, tid, wave, lane);
        }
        if (bx >= half) { PHASE_IDS();
            for (int j = bx - half; j < 256; j += G - half) p4_ret_item(A, lds, j >> 6, (j >> 2) & 15, j & 3, tid, wave, lane);
        }
    }
#endif
    GRID_SYNC();

#ifndef SK5
    {
        pg8::Gemm g{(const bf16_t*)(ws + WS_HBUF), (const bf16_t*)(ws + WS_WOUT), NT, DM, DM}; pg8::StaticOrder S; S.init(NT, DM, G, bx);
        EpiOutProj E{A.x, A.out, (bf16_t*)(ws + WS_H2W), A.norm_mlp_w, (float*)(ws + WS_SSQ2)};
        pg8::gemm_phase<EpiOutProj, pg8::StaticOrder, true, true>(lds, g, S, E);
    }
#endif
    GRID_SYNC();

#ifndef SK6
    {
        pg8::Gemm g{(const bf16_t*)(ws + WS_H2W), (const bf16_t*)(ws + WS_WUP), NT, DFF, DM}; pg8::StaticOrder S; S.init(NT, DFF, G, bx);
        EpiUp E{(bf16_t*)(ws + WS_U), (const float*)(ws + WS_SSQ2)};
        for (int rep_ = 0; rep_ < REP6; ++rep_) pg8::gemm_phase<EpiUp, pg8::StaticOrder, true, true>(lds, g, S, E);
    }
#endif
    GRID_SYNC();

#ifndef SK7
    {
        pg8::Gemm g{(const bf16_t*)(ws + WS_U), (const bf16_t*)(ws + WS_WDN), NT, DM, DFF}; pg8::StaticOrder S; S.init(NT, DM, G, bx);
        EpiDown E{A.out, (float*)(ws + WS_SSQ3)};
        pg8::gemm_phase<EpiDown, pg8::StaticOrder, true, true>(lds, g, S, E);
    }
#endif
    GRID_SYNC();

    { PHASE_IDS();
    for (int m = gw; m < NT; m += ngw) {
        const float* sp = (const float*)(ws + WS_SSQ3) + (size_t)m * 32;
        const float s = wave_sum(lane < 32 ? sp[lane] : 0.f);
        const float rs = rsqrtf(s * (1.f / DM) + EPS);
        f32x4* o = (f32x4*)(A.out + (size_t)m * DM) + lane; const f32x4* wv = (const f32x4*)A.norm_final_w + lane;
#pragma unroll
        for (int j = 0; j < 8; ++j) { f32x4 v = o[64 * j]; const f32x4 w = wv[64 * j]; v = v * rs * w; o[64 * j] = v; }
    }
    }
}

extern "C" void kernel_launch(void* const* d_in, const int* in_sizes, int n_in, void* d_out, int out_size, void* d_ws, size_t ws_size, hipStream_t stream) {
    static int grid = 0;
    if (grid == 0) {
        int dev = 0, cus = 0, per_cu = 0;
        hipGetDevice(&dev);
        hipDeviceGetAttribute(&cus, hipDeviceAttributeMultiprocessorCount, dev);
        hipFuncSetAttribute((const void*)hymba_fwd, hipFuncAttributeMaxDynamicSharedMemorySize, LDS_BYTES);
        hipOccupancyMaxActiveBlocksPerMultiprocessor(&per_cu, (const void*)hymba_fwd, 512, LDS_BYTES);
        if (per_cu < 1 || cus < 1 || n_in != 15 || ws_size < 256 * MiB) { fprintf(stderr, "kernel_launch: bad configuration (cus %d per_cu %d n_in %d ws %zu)\n", cus, per_cu, n_in, ws_size); grid = -1; }
        else grid = cus * per_cu;
    }
    if (grid < 0) return;
    Args a{};
    a.x = (const float*)d_in[0]; a.norm_mix_w = (const float*)d_in[1]; a.w_in = (const float*)d_in[2]; a.ret_norm_w = (const float*)d_in[3];
    a.conv_w = (const float*)d_in[4]; a.conv_b = (const float*)d_in[5]; a.dt_bias = (const float*)d_in[6]; a.a_log = (const float*)d_in[7];
    a.d_skip = (const float*)d_in[8]; a.ssd_norm_w = (const float*)d_in[9]; a.w_out = (const float*)d_in[10]; a.norm_mlp_w = (const float*)d_in[11];
    a.w_up = (const float*)d_in[12]; a.w_down = (const float*)d_in[13]; a.norm_final_w = (const float*)d_in[14];
    a.out = (float*)d_out; a.ws = (unsigned char*)d_ws;
    if (hipMemsetAsync((char*)d_ws + WS_CTL, 0, 16384, stream) != hipSuccess) { fprintf(stderr, "memset failed\n"); return; }
    void* args[] = {&a};
    hipError_t e = hipLaunchCooperativeKernel((const void*)hymba_fwd, dim3(grid), dim3(512), args, LDS_BYTES, stream);
    if (e != hipSuccess) fprintf(stderr, "cooperative launch failed: %s (grid %d)\n", hipGetErrorString(e), grid);
}
```

```cpp
#include <hip/hip_runtime.h>
#include <hip/hip_cooperative_groups.h>
#include <cstdio>
#include <cstdint>
namespace cg = cooperative_groups;
namespace pg8 {
#define PG8_LAS __attribute__((address_space(3)))
typedef unsigned short bf16_t;
typedef short bf16x8 __attribute__((ext_vector_type(8)));
typedef float f32x4 __attribute__((ext_vector_type(4)));
typedef unsigned u32x4 __attribute__((ext_vector_type(4)));
constexpr int BM = 256, BK = 64, HALF = 128, HTB = HALF * BK * 2  , STAGE_BYTES = 8 * HTB, NXCD = 8, WGM = 8;

__host__ __device__ __forceinline__ int lds_byte(int r, int c) { const int st = (r >> 4) * 2 + (c >> 5), rr = r & 15, cc = c & 31, ob = rr * 64 + cc * 2; return st * 1024 + (ob ^ (((ob >> 9) & 1) << 5)); }
__host__ __device__ __forceinline__ void stage_rc(int b, int& R, int& C) { const int st = b / 1024, sb = b % 1024, swz = sb ^ (((sb >> 9) & 1) << 5); R = (st >> 1) * 16 + swz / 64; C = (st & 1) * 32 + (swz % 64) / 2; }
__host__ __device__ __forceinline__ int perm32(int rho) { const int n = rho >> 4, i = rho & 15; return 8 * (i >> 2) + 4 * n + (i & 3); }

struct Unit { int pm, pn; };
struct Gemm { const bf16_t* A; const bf16_t* Bt; int M, N, K; };

struct StaticOrder {
    int nM, nN, nwg, G, c;
    __host__ __device__ void init(int M, int N, int G_, int c_) { nM = M / BM; nN = N / BM; nwg = nM * nN; G = G_; c = c_; }
    __host__ __device__ bool next(int i, Unit& u) const {
        const long L = (long)i * G + c; if (L >= nwg) return false;
        int wgid = (int)L; { const int q = nwg / NXCD, r = nwg % NXCD, xcd = wgid % NXCD, off = wgid / NXCD; wgid = (xcd < r ? xcd * (q + 1) : r * (q + 1) + (xcd - r) * q) + off; }
        const int nig = WGM * nN, gid = wgid / nig, fm = gid * WGM, gsz = (nM - fm) < WGM ? (nM - fm) : WGM;
        u.pm = fm + ((wgid % nig) % gsz); u.pn = (wgid % nig) / gsz; return true;
    }
    __device__ __forceinline__ void a_ready(const Unit&) const {}
    __device__ __forceinline__ void done(const Unit&) const {}
};
typedef float f32x2_cv __attribute__((ext_vector_type(2))); typedef __bf16 bf16x2_cv __attribute__((ext_vector_type(2)));
__device__ __forceinline__ unsigned cvt_pk_bf16(float lo, float hi) { const f32x2_cv v = {lo, hi}; const bf16x2_cv b = __builtin_convertvector(v, bf16x2_cv); return __builtin_bit_cast(unsigned, b); }
typedef float f32x2 __attribute__((ext_vector_type(2)));
template <class Epi, class Sched, bool ALIGN_EPI = false, bool SP2 = false>
__device__ __forceinline__ void gemm_phase(PG8_LAS unsigned char* lds, const Gemm g, const Sched& S, const Epi& E) {
    int tid_l = threadIdx.x; asm volatile("" : "+v"(tid_l));
    const int tid = tid_l, wid = __builtin_amdgcn_readfirstlane(tid >> 6), lane = tid & 63, wr = wid >> 2, wc = wid & 3, fr = lane & 15, fq = lane >> 4;
    const int K = g.K, nt = K / BK;
    unsigned voffA[2], voffB[2];
#pragma unroll
    for (int i = 0; i < 2; ++i) { int R, C; stage_rc(tid * 16 + i * 8192, R, C); const int Rb = Epi::PERM ? ((R & ~31) + perm32(R & 31)) : R;
        voffA[i] = (unsigned)(R * K + C) * 2u; voffB[i] = (unsigned)(Rb * K + C) * 2u; }
    const size_t kstep = (size_t)(BK * 2);
    const size_t hstep = (size_t)HALF * K * 2;
    const size_t tstep = 2 * hstep;
    const unsigned ldsw = (unsigned)wid * 1024u;
    const int aoff = lds_byte(wr * 64 + fr, fq * 8), boff = lds_byte(wc * 32 + fr, fq * 8);
#define PG8_SA(b, h) (((b) * 2 + (h)) * HTB)
#define PG8_SB(b, h) ((4 + (b) * 2 + (h)) * HTB)
#define PG8_STAGE(bufoff, gbase, voff) do { _Pragma("unroll") for (int _i = 0; _i < 2; ++_i) \
        __builtin_amdgcn_global_load_lds((const unsigned*)((const char*)(gbase) + (voff)[_i]), (PG8_LAS unsigned*)(lds + (bufoff) + ldsw + _i * 8192), 16, 0, 0); } while (0)
#define PG8_LDA(dst, b, h) do { _Pragma("unroll") for (int m = 0; m < 4; ++m) _Pragma("unroll") for (int k = 0; k < 2; ++k) dst[m][k] = *(const PG8_LAS bf16x8*)(lds + PG8_SA(b, h) + aoff + m * 2048 + k * 1024); } while (0)
#define PG8_LDB(dst, b, h) do { _Pragma("unroll") for (int n = 0; n < 2; ++n) _Pragma("unroll") for (int k = 0; k < 2; ++k) dst[n][k] = *(const PG8_LAS bf16x8*)(lds + PG8_SB(b, h) + boff + n * 2048 + k * 1024); } while (0)
#define PG8_MMA(ai, bj, At, Bt) do { __builtin_amdgcn_s_setprio(1); _Pragma("unroll") for (int m = 0; m < 4; ++m) _Pragma("unroll") for (int n = 0; n < 2; ++n) _Pragma("unroll") for (int k = 0; k < 2; ++k) \
        acc[ai][bj][m][n] = __builtin_amdgcn_mfma_f32_16x16x32_bf16(Bt[n][k], At[m][k], acc[ai][bj][m][n], 0, 0, 0); __builtin_amdgcn_s_setprio(0); } while (0)
#define PG8_WAIT_V(n) asm volatile("s_waitcnt vmcnt(" #n ")" ::: "memory")
#define PG8_WAIT_L(n) asm volatile("s_waitcnt lgkmcnt(" #n ")" ::: "memory")
#define PG8_BAR __builtin_amdgcn_s_barrier()
#define PG8_SCHED __builtin_amdgcn_sched_barrier(0)
    Unit cur, nxt; int ui = 0;
    if (!S.next(0, cur)) return;
    f32x4 acc[2][2][4][2];
#pragma unroll
    for (int a = 0; a < 2; ++a)
#pragma unroll
        for (int b = 0; b < 2; ++b)
#pragma unroll
            for (int m = 0; m < 4; ++m)
#pragma unroll
                for (int n = 0; n < 2; ++n) acc[a][b][m][n] = (f32x4){0.f, 0.f, 0.f, 0.f};
    bf16x8 At[4][2], B0[2][2], B1[2][2];
    const char* cA = (const char*)g.A + (size_t)cur.pm * tstep; const char* cB = (const char*)g.Bt + (size_t)cur.pn * tstep;
    S.a_ready(cur);
    if constexpr (SP2) {
        PG8_STAGE(PG8_SB(0, 0), cB, voffB); PG8_STAGE(PG8_SB(0, 1), cB + hstep, voffB); PG8_STAGE(PG8_SA(0, 0), cA, voffA); PG8_STAGE(PG8_SA(0, 1), cA + hstep, voffA);
        if (wr == 1) PG8_BAR;
        PG8_WAIT_V(2); PG8_BAR;
        PG8_STAGE(PG8_SB(1, 0), cB + kstep, voffB); PG8_STAGE(PG8_SA(1, 0), cA + kstep, voffA); PG8_STAGE(PG8_SB(1, 1), cB + hstep + kstep, voffB);
        PG8_WAIT_V(6); PG8_BAR;
    } else {
        PG8_STAGE(PG8_SB(0, 0), cB, voffB); PG8_STAGE(PG8_SA(0, 0), cA, voffA); PG8_STAGE(PG8_SB(0, 1), cB + hstep, voffB); PG8_STAGE(PG8_SA(0, 1), cA + hstep, voffA);
        if (wr == 1) PG8_BAR;
        PG8_WAIT_V(4); PG8_BAR;
        PG8_STAGE(PG8_SB(1, 0), cB + kstep, voffB); PG8_STAGE(PG8_SA(1, 0), cA + kstep, voffA); PG8_STAGE(PG8_SB(1, 1), cB + hstep + kstep, voffB);
        PG8_WAIT_V(6); PG8_BAR;
    }
    for (;;) {
        const bool has_next = S.next(ui + 1, nxt);
        const char* nA = has_next ? (const char*)g.A + (size_t)nxt.pm * tstep : cA; const char* nB = has_next ? (const char*)g.Bt + (size_t)nxt.pn * tstep : cB;
        for (int t = 0; t < nt; t += 2) {
            const bool last = (t == nt - 2);
            const char* a1 = cA + (size_t)(t + 1) * kstep;
            const char* a2 = last ? nA : cA + (size_t)(t + 2) * kstep; const char* b2 = last ? nB : cB + (size_t)(t + 2) * kstep;
            const char* a3 = a2 + kstep; const char* b3 = b2 + kstep;
            if (last && has_next) S.a_ready(nxt);
            if constexpr (SP2) {
            PG8_LDB(B0, 0, 0); PG8_LDB(B1, 0, 1); PG8_SCHED; PG8_LDA(At, 0, 0); PG8_STAGE(PG8_SA(1, 1), a1 + hstep, voffA);
            PG8_WAIT_V(8); PG8_WAIT_L(0); PG8_BAR; PG8_MMA(0, 0, At, B0); PG8_MMA(0, 1, At, B1); PG8_BAR; PG8_SCHED;
            PG8_LDA(At, 0, 1); PG8_STAGE(PG8_SB(0, 0), b2, voffB); PG8_STAGE(PG8_SB(0, 1), b2 + hstep, voffB); PG8_STAGE(PG8_SA(0, 0), a2, voffA);
            PG8_WAIT_V(8); PG8_WAIT_L(0); PG8_BAR; PG8_MMA(1, 0, At, B0); PG8_MMA(1, 1, At, B1); PG8_BAR; PG8_SCHED;
            PG8_LDB(B0, 1, 0); PG8_LDB(B1, 1, 1); PG8_SCHED; PG8_LDA(At, 1, 0); PG8_STAGE(PG8_SA(0, 1), a2 + hstep, voffA);
            PG8_WAIT_V(8); PG8_WAIT_L(0); PG8_BAR; PG8_MMA(0, 0, At, B0); PG8_MMA(0, 1, At, B1); PG8_BAR; PG8_SCHED;
            PG8_LDA(At, 1, 1); PG8_STAGE(PG8_SB(1, 0), b3, voffB); PG8_STAGE(PG8_SB(1, 1), b3 + hstep, voffB); PG8_STAGE(PG8_SA(1, 0), a3, voffA);
            PG8_WAIT_V(8); PG8_WAIT_L(0); PG8_BAR; PG8_MMA(1, 0, At, B0); PG8_MMA(1, 1, At, B1); PG8_BAR; PG8_SCHED;
            } else {
            PG8_LDB(B0, 0, 0); PG8_SCHED; PG8_LDA(At, 0, 0); PG8_STAGE(PG8_SA(1, 1), a1 + hstep, voffA);
            PG8_WAIT_L(8); PG8_BAR; PG8_WAIT_L(0); PG8_MMA(0, 0, At, B0); PG8_BAR; PG8_SCHED;
            PG8_LDB(B1, 0, 1); PG8_STAGE(PG8_SB(0, 0), b2, voffB);
            PG8_BAR; PG8_WAIT_L(0); PG8_MMA(0, 1, At, B1); PG8_BAR;
            PG8_LDA(At, 0, 1); PG8_STAGE(PG8_SA(0, 0), a2, voffA);
            PG8_BAR; PG8_WAIT_L(0); PG8_MMA(1, 0, At, B0); PG8_BAR; PG8_SCHED;
            PG8_STAGE(PG8_SB(0, 1), b2 + hstep, voffB);
            PG8_WAIT_V(6); PG8_BAR; PG8_MMA(1, 1, At, B1); PG8_BAR;
            PG8_LDB(B0, 1, 0); PG8_SCHED; PG8_LDA(At, 1, 0); PG8_STAGE(PG8_SA(0, 1), a2 + hstep, voffA);
            PG8_WAIT_L(8); PG8_BAR; PG8_WAIT_L(0); PG8_MMA(0, 0, At, B0); PG8_BAR; PG8_SCHED;
            PG8_LDB(B1, 1, 1); PG8_STAGE(PG8_SB(1, 0), b3, voffB);
            PG8_BAR; PG8_WAIT_L(0); PG8_MMA(0, 1, At, B1); PG8_BAR;
            PG8_LDA(At, 1, 1); PG8_STAGE(PG8_SA(1, 0), a3, voffA);
            PG8_BAR; PG8_WAIT_L(0); PG8_MMA(1, 0, At, B0); PG8_BAR; PG8_SCHED;
            PG8_STAGE(PG8_SB(1, 1), b3 + hstep, voffB);
            PG8_WAIT_V(6); PG8_BAR; PG8_MMA(1, 1, At, B1); PG8_BAR;
            }
        }
        if constexpr (ALIGN_EPI) { if (wr == 0) PG8_BAR; }
        if constexpr (!Epi::AFTER_DRAIN) { E(acc, cur, wr, wc, fr, fq); S.done(cur); }
        if (!has_next) break;
#pragma unroll
        for (int a = 0; a < 2; ++a)
#pragma unroll
            for (int b = 0; b < 2; ++b)
#pragma unroll
                for (int m = 0; m < 4; ++m)
#pragma unroll
                    for (int n = 0; n < 2; ++n) acc[a][b][m][n] = (f32x4){0.f, 0.f, 0.f, 0.f};
        cur = nxt; cA = nA; cB = nB; ++ui;
        if constexpr (ALIGN_EPI) { if (wr == 1) PG8_BAR; }
    }
    PG8_WAIT_V(0);
    if constexpr (!ALIGN_EPI) { if (wr == 0) PG8_BAR; }
    PG8_BAR;
    if constexpr (Epi::AFTER_DRAIN) { E.fused(acc, cur, wr, wc, fr, fq, lds, wid, lane); S.done(cur); }
#undef PG8_SA
#undef PG8_SB
#undef PG8_STAGE
#undef PG8_LDA
#undef PG8_LDB
#undef PG8_MMA
#undef PG8_WAIT_V
#undef PG8_WAIT_L
#undef PG8_BAR
#undef PG8_SCHED
}
}

using pg8::bf16_t; using pg8::bf16x8; using pg8::f32x4; using pg8::u32x4; using pg8::Unit; using pg8::cvt_pk_bf16;
#define LAS __attribute__((address_space(3)))
typedef short s16x4 __attribute__((ext_vector_type(4)));

constexpr int NT = 8192;
constexpr int SEQ = 2048, DM = 2048, DFF = 8192, INW = 6672, INW_PAD = 6912;
constexpr int CONVD = 1536;
constexpr float EPS = 1e-6f;
constexpr size_t MiB = 1u << 20;
constexpr size_t WS_HBUF = 0;
constexpr size_t WS_Q = 32 * MiB, WS_K = 48 * MiB, WS_V = 64 * MiB, WS_G = 80 * MiB, WS_Z = 96 * MiB;
constexpr int XB_ST_OFF = 139264 + 128;
constexpr size_t WS_U = 0;
constexpr size_t WS_WUP = 128 * MiB;
constexpr size_t OUT_WIN = 0, OUT_SS = 0, OUT_SR = 16 * MiB;
constexpr size_t WS_WDN = 160 * MiB;
constexpr size_t WS_XBC = 192 * MiB;
constexpr size_t WS_DT = 216 * MiB;
constexpr size_t WS_ACS = 217 * MiB;
constexpr size_t WS_H2W = 192 * MiB;
constexpr size_t WS_XC = 224 * MiB;
constexpr size_t WS_SSQ2 = 224 * MiB;
constexpr size_t WS_SSQ3 = 225 * MiB;
constexpr size_t WS_WOUT = 112 * MiB;
constexpr size_t WS_CTL = 248 * MiB;
constexpr int LDS_BYTES = 139264 + 256;
#ifndef REP0
#define REP0 1
#endif
#ifndef REP2
#define REP2 1
#endif
#ifndef REP4
#define REP4 1
#endif
#ifndef REP5
#define REP5 1
#endif
#ifndef REP6
#define REP6 1
#endif

struct Args {
    const float* x; const float* norm_mix_w; const float* w_in; const float* ret_norm_w; const float* conv_w; const float* conv_b;
    const float* dt_bias; const float* a_log; const float* d_skip; const float* ssd_norm_w; const float* w_out; const float* norm_mlp_w;
    const float* w_up; const float* w_down; const float* norm_final_w;
    float* out; unsigned char* ws;
};

__device__ __forceinline__ float bf2f(unsigned short b) { return __builtin_bit_cast(float, (unsigned)b << 16); }
__device__ __forceinline__ float bflo(unsigned w) { return __builtin_bit_cast(float, w << 16); }
__device__ __forceinline__ float bfhi(unsigned w) { return __builtin_bit_cast(float, w & 0xffff0000u); }
__device__ __forceinline__ unsigned short f2bf(float f) { return (unsigned short)(cvt_pk_bf16(f, 0.f) & 0xffffu); }
__device__ __forceinline__ float silu_f(float x) { return x / (1.f + __expf(-x)); }
__device__ __forceinline__ float wave_sum(float v) {
#pragma unroll
    for (int o = 1; o < 64; o <<= 1) v += __shfl_xor(v, o);
    return v;
}
__device__ __forceinline__ f32x4 mfma16(bf16x8 a, bf16x8 b, f32x4 c) { return __builtin_amdgcn_mfma_f32_16x16x32_bf16(a, b, c, 0, 0, 0); }
__device__ __forceinline__ bf16x8 frag_row(const LAS unsigned char* base, int pitchB, int r0, int c0, int lane) {
    return *(const LAS bf16x8*)(base + (r0 + (lane & 15)) * pitchB + (c0 + 8 * (lane >> 4)) * 2);
}
__device__ __forceinline__ bf16x8 frag_tr(const LAS unsigned char* base, int pitchB, int k0, int c0, int lane) {
    const int g = lane >> 4, q = (lane & 15) >> 2, p = lane & 3;
    const LAS unsigned char* a = base + (k0 + 8 * g + q) * pitchB + (c0 + 4 * p) * 2;
    const s16x4 lo = __builtin_amdgcn_ds_read_tr16_b64_v4i16((LAS s16x4*)a);
    const s16x4 hi = __builtin_amdgcn_ds_read_tr16_b64_v4i16((LAS s16x4*)(a + 4 * pitchB));
    bf16x8 r; r[0] = lo[0]; r[1] = lo[1]; r[2] = lo[2]; r[3] = lo[3]; r[4] = hi[0]; r[5] = hi[1]; r[6] = hi[2]; r[7] = hi[3];
    return r;
}
__device__ __forceinline__ bf16x8 gfrag_row(const bf16_t* base, int ld, int r0, int c0, int lane) {
    return *(const bf16x8*)(base + (size_t)(r0 + (lane & 15)) * ld + c0 + 8 * (lane >> 4));
}
#define WAVE_LDS_SYNC() asm volatile("s_waitcnt lgkmcnt(0)" ::: "memory")

struct EpiInProj {
    static constexpr bool PERM = true, AFTER_DRAIN = false;
    bf16_t *qkvgz, *xbc; float* dt; const float* dt_bias;
    __device__ __forceinline__ void operator()(const f32x4 (&acc)[2][2][4][2], const Unit& u, int wr, int wc, int fr, int fq) const {
        const int row0 = u.pm * 256 + wr * 64 + fr, pn = u.pn, cw = wc * 32 + 8 * fq;
        if (pn < 8) {
            bf16_t* base = qkvgz + (size_t)(pn >> 2) * (size_t)(NT * 1024); const float sc = (pn < 4) ? 1.f : 0.0625f; const int hc = (pn & 3) * 256;
            float invf[2][4];
#pragma unroll
            for (int n = 0; n < 2; ++n)
#pragma unroll
                for (int j = 0; j < 4; ++j) invf[n][j] = exp2f(-(float)(cw + 4 * n + j) * (13.287712379549449f / 128.f)) * 0.15915494309189535f;
#pragma unroll
            for (int ai = 0; ai < 2; ++ai)
#pragma unroll
                for (int m = 0; m < 4; ++m) {
                    const int row = row0 + ai * 128 + m * 16; const float pos = (float)(row & (SEQ - 1));
                    float o1[8], o2[8];
#pragma unroll
                    for (int n = 0; n < 2; ++n)
#pragma unroll
                        for (int j = 0; j < 4; ++j) {
                            float rev = pos * invf[n][j]; rev -= floorf(rev);
                            const float s = __builtin_amdgcn_sinf(rev), c = __builtin_amdgcn_cosf(rev);
                            const float x1 = acc[ai][0][m][n][j], x2 = acc[ai][1][m][n][j];
                            o1[n * 4 + j] = (x1 * c - x2 * s) * sc; o2[n * 4 + j] = (x1 * s + x2 * c) * sc;
                        }
                    u32x4 w1, w2;
                    w1.x = cvt_pk_bf16(o1[0], o1[1]); w1.y = cvt_pk_bf16(o1[2], o1[3]); w1.z = cvt_pk_bf16(o1[4], o1[5]); w1.w = cvt_pk_bf16(o1[6], o1[7]);
                    w2.x = cvt_pk_bf16(o2[0], o2[1]); w2.y = cvt_pk_bf16(o2[2], o2[3]); w2.z = cvt_pk_bf16(o2[4], o2[5]); w2.w = cvt_pk_bf16(o2[6], o2[7]);
                    bf16_t* rp = base + (size_t)row * 1024 + hc + cw;
                    *(u32x4*)rp = w1; *(u32x4*)(rp + 128) = w2;
                }
        } else if (pn < 26) {
            bf16_t* base; int ld, hc; bool act;
            if (pn < 20) { base = qkvgz + (size_t)(pn >> 2) * (size_t)(NT * 1024); act = (pn >= 12); ld = 1024; hc = (pn & 3) * 256; }
            else { base = xbc; act = false; ld = CONVD; hc = (pn - 20) * 256; }
#pragma unroll
            for (int ai = 0; ai < 2; ++ai)
#pragma unroll
                for (int m = 0; m < 4; ++m) {
                    bf16_t* rp = base + (size_t)(row0 + ai * 128 + m * 16) * ld + hc + cw;
#pragma unroll
                    for (int bj = 0; bj < 2; ++bj) {
                        f32x4 v0 = acc[ai][bj][m][0], v1 = acc[ai][bj][m][1];
                        if (act) {
#pragma unroll
                            for (int j = 0; j < 4; ++j) { v0[j] = silu_f(v0[j]); v1[j] = silu_f(v1[j]); }
                        }
                        u32x4 w; w.x = cvt_pk_bf16(v0[0], v0[1]); w.y = cvt_pk_bf16(v0[2], v0[3]); w.z = cvt_pk_bf16(v1[0], v1[1]); w.w = cvt_pk_bf16(v1[2], v1[3]);
                        *(u32x4*)(rp + bj * 128) = w;
                    }
                }
        } else {
            if (wc == 0 && fq < 2) {
#pragma unroll
                for (int ai = 0; ai < 2; ++ai)
#pragma unroll
                    for (int m = 0; m < 4; ++m) {
                        const int row = row0 + ai * 128 + m * 16;
#pragma unroll
                        for (int n = 0; n < 2; ++n) {
                            f32x4 o;
#pragma unroll
                            for (int j = 0; j < 4; ++j) { const float xv = acc[ai][0][m][n][j] + dt_bias[8 * fq + 4 * n + j]; o[j] = (xv > 20.f) ? xv : log1pf(__expf(xv)); }
                            *(f32x4*)(dt + (size_t)row * 16 + 8 * fq + 4 * n) = o;
                        }
                    }
            }
        }
    }
};
struct EpiOutProj {
    static constexpr bool PERM = true, AFTER_DRAIN = false;
    const float* x; float* h2; bf16_t* h2w; const float* nw; float* ssq;
    __device__ __forceinline__ void operator()(const f32x4 (&acc)[2][2][4][2], const Unit& u, int wr, int wc, int fr, int fq) const {
        const int row0 = u.pm * 256 + wr * 64 + fr, c0 = u.pn * 256 + wc * 32 + 8 * fq;
#pragma unroll
        for (int ai = 0; ai < 2; ++ai)
#pragma unroll
            for (int m = 0; m < 4; ++m) {
                const int row = row0 + ai * 128 + m * 16; float ss = 0.f;
#pragma unroll
                for (int bj = 0; bj < 2; ++bj) {
                    const size_t off = (size_t)row * DM + c0 + bj * 128;
                    const f32x4 x0 = *(const f32x4*)(x + off), x1 = *(const f32x4*)(x + off + 4);
                    const f32x4 v0 = acc[ai][bj][m][0] + x0, v1 = acc[ai][bj][m][1] + x1;
                    *(f32x4*)(h2 + off) = v0; *(f32x4*)(h2 + off + 4) = v1;
                    ss += (v0[0] * v0[0] + v0[1] * v0[1]) + (v0[2] * v0[2] + v0[3] * v0[3]) + (v1[0] * v1[0] + v1[1] * v1[1]) + (v1[2] * v1[2] + v1[3] * v1[3]);
                    const f32x4 w0 = *(const f32x4*)(nw + c0 + bj * 128), w1 = *(const f32x4*)(nw + c0 + bj * 128 + 4);
                    u32x4 w; w.x = cvt_pk_bf16(v0[0] * w0[0], v0[1] * w0[1]); w.y = cvt_pk_bf16(v0[2] * w0[2], v0[3] * w0[3]);
                    w.z = cvt_pk_bf16(v1[0] * w1[0], v1[1] * w1[1]); w.w = cvt_pk_bf16(v1[2] * w1[2], v1[3] * w1[3]);
                    *(u32x4*)(h2w + off) = w;
                }
                ss += __shfl_xor(ss, 16); ss += __shfl_xor(ss, 32);
                if (fq == 0) ssq[(size_t)row * 32 + u.pn * 4 + wc] = ss;
            }
    }
};
__device__ __forceinline__ float row_rstd(const float* ssq, int row) {
    const f32x4* p = (const f32x4*)(ssq + (size_t)row * 32); float s = 0.f;
#pragma unroll
    for (int i = 0; i < 8; ++i) { const f32x4 t = p[i]; s += (t[0] + t[1]) + (t[2] + t[3]); }
    return rsqrtf(s * (1.f / DM) + EPS);
}
struct EpiUp {
    static constexpr bool PERM = true, AFTER_DRAIN = false;
    bf16_t* U; const float* ssq;
    __device__ __forceinline__ void operator()(const f32x4 (&acc)[2][2][4][2], const Unit& u, int wr, int wc, int fr, int fq) const {
        const int row0 = u.pm * 256 + wr * 64 + fr, c0 = u.pn * 256 + wc * 32 + 8 * fq;
#pragma unroll
        for (int ai = 0; ai < 2; ++ai)
#pragma unroll
            for (int m = 0; m < 4; ++m) {
                const int row = row0 + ai * 128 + m * 16; const float rs = row_rstd(ssq, row);
#pragma unroll
                for (int bj = 0; bj < 2; ++bj) {
                    f32x4 v0 = acc[ai][bj][m][0] * rs, v1 = acc[ai][bj][m][1] * rs;
#pragma unroll
                    for (int j = 0; j < 4; ++j) { const float a = fmaxf(v0[j], 0.f), b = fmaxf(v1[j], 0.f); v0[j] = a * a; v1[j] = b * b; }
                    u32x4 w; w.x = cvt_pk_bf16(v0[0], v0[1]); w.y = cvt_pk_bf16(v0[2], v0[3]); w.z = cvt_pk_bf16(v1[0], v1[1]); w.w = cvt_pk_bf16(v1[2], v1[3]);
                    *(u32x4*)(U + (size_t)row * DFF + c0 + bj * 128) = w;
                }
            }
    }
};
struct EpiDown {
    static constexpr bool PERM = true, AFTER_DRAIN = false;
    float* h; float* ssq;
    __device__ __forceinline__ void operator()(const f32x4 (&acc)[2][2][4][2], const Unit& u, int wr, int wc, int fr, int fq) const {
        const int row0 = u.pm * 256 + wr * 64 + fr, c0 = u.pn * 256 + wc * 32 + 8 * fq;
#pragma unroll
        for (int ai = 0; ai < 2; ++ai)
#pragma unroll
            for (int m = 0; m < 4; ++m) {
                const int row = row0 + ai * 128 + m * 16; float ss = 0.f;
#pragma unroll
                for (int bj = 0; bj < 2; ++bj) {
                    const size_t off = (size_t)row * DM + c0 + bj * 128;
                    const f32x4 x0 = *(const f32x4*)(h + off), x1 = *(const f32x4*)(h + off + 4);
                    const f32x4 v0 = acc[ai][bj][m][0] + x0, v1 = acc[ai][bj][m][1] + x1;
                    *(f32x4*)(h + off) = v0; *(f32x4*)(h + off + 4) = v1;
                    ss += (v0[0] * v0[0] + v0[1] * v0[1]) + (v0[2] * v0[2] + v0[3] * v0[3]) + (v1[0] * v1[0] + v1[1] * v1[1]) + (v1[2] * v1[2] + v1[3] * v1[3]);
                }
                ss += __shfl_xor(ss, 16); ss += __shfl_xor(ss, 32);
                if (fq == 0) ssq[(size_t)row * 32 + u.pn * 4 + wc] = ss;
            }
    }
};

__device__ __forceinline__ void transpose_item(const float* W, int K, int N, bf16_t* WT, LAS float* scr, int item, int lane) {
    const int nblk = (N + 63) >> 6, kb = item / nblk, nb = item - kb * nblk, k0 = kb * 64, n0 = nb * 64;
    const int n4 = (lane & 15) * 4, kr = lane >> 4;
#pragma unroll 4
    for (int i = 0; i < 16; ++i) {
        const int kk = i * 4 + kr;
        f32x4 v = (f32x4){0.f, 0.f, 0.f, 0.f};
        if (n0 + n4 < N) v = *(const f32x4*)(W + (size_t)(k0 + kk) * N + n0 + n4);
        LAS float* s = scr + kk * 65 + n4; s[0] = v[0]; s[1] = v[1]; s[2] = v[2]; s[3] = v[3];
    }
    WAVE_LDS_SYNC();
    const int c = lane & 7;
#pragma unroll
    for (int j = 0; j < 8; ++j) {
        const int n = j * 8 + (lane >> 3); const LAS float* s = scr + (8 * c) * 65 + n;
        u32x4 o; o.x = cvt_pk_bf16(s[0], s[65]); o.y = cvt_pk_bf16(s[2 * 65], s[3 * 65]); o.z = cvt_pk_bf16(s[4 * 65], s[5 * 65]); o.w = cvt_pk_bf16(s[6 * 65], s[7 * 65]);
        if (n0 + n < N) *(u32x4*)(WT + (size_t)(n0 + n) * K + k0 + 8 * c) = o;
    }
    WAVE_LDS_SYNC();
}
__device__ __forceinline__ void transpose_weight(const float* W, int K, int N, bf16_t* WT, LAS unsigned char* lds, int gw, int ngw, int wave, int lane) {
    LAS float* scr = (LAS float*)(lds + wave * (64 * 65 * 4));
    const int nitems = (K >> 6) * ((N + 63) >> 6);
    for (int it = gw; it < nitems; it += ngw) transpose_item(W, K, N, WT, scr, it, lane);
}
__device__ __forceinline__ void rms_row_bf16(const float* xrow, const float* w, bf16_t* orow, int lane) {
    const f32x4* xr = (const f32x4*)xrow + lane; f32x4 v[8]; float s = 0.f;
#pragma unroll
    for (int j = 0; j < 8; ++j) { v[j] = xr[64 * j]; s += (v[j][0] * v[j][0] + v[j][1] * v[j][1]) + (v[j][2] * v[j][2] + v[j][3] * v[j][3]); }
    const float rs = rsqrtf(wave_sum(s) * (1.f / DM) + EPS);
    const f32x4* wr = (const f32x4*)w + lane;
    unsigned long long* o8 = (unsigned long long*)orow + lane;
#pragma unroll
    for (int j = 0; j < 8; ++j) { const f32x4 ww = wr[64 * j];
        o8[64 * j] = (unsigned long long)cvt_pk_bf16(v[j][0] * rs * ww[0], v[j][1] * rs * ww[1]) | ((unsigned long long)cvt_pk_bf16(v[j][2] * rs * ww[2], v[j][3] * rs * ww[3]) << 32); }
}

constexpr int P264 = 528, P136 = 272;
constexpr int T264 = 128 * P264, T136 = 128 * P136;

__device__ __forceinline__ float ret_log2_gamma(int h) { return log2f(1.f - exp2f(-5.f - (float)h)); }

__device__ __forceinline__ void conv_silu8(const bf16_t* XBC, const float* cw, const float* cb, int b, int s, int col, float (&o)[8]) {
    { const f32x4 b0 = *(const f32x4*)(cb + col), b1 = *(const f32x4*)(cb + col + 4);
      o[0] = b0[0]; o[1] = b0[1]; o[2] = b0[2]; o[3] = b0[3]; o[4] = b1[0]; o[5] = b1[1]; o[6] = b1[2]; o[7] = b1[3]; }
#pragma unroll
    for (int j = 0; j < 4; ++j) {
        const int sj = s - 3 + j;
        if (sj >= 0) {
            const u32x4 r = *(const u32x4*)(XBC + (size_t)(b * SEQ + sj) * CONVD + col);
            const f32x4 w0 = *(const f32x4*)(cw + j * CONVD + col), w1 = *(const f32x4*)(cw + j * CONVD + col + 4);
            o[0] += w0[0] * bflo(r.x); o[1] += w0[1] * bfhi(r.x); o[2] += w0[2] * bflo(r.y); o[3] += w0[3] * bfhi(r.y);
            o[4] += w1[0] * bflo(r.z); o[5] += w1[1] * bfhi(r.z); o[6] += w1[2] * bflo(r.w); o[7] += w1[3] * bfhi(r.w);
        }
    }
#pragma unroll
    for (int i = 0; i < 8; ++i) o[i] = silu_f(o[i]);
}
__device__ __forceinline__ u32x4 pack8(const float (&o)[8]) {
    u32x4 w; w.x = cvt_pk_bf16(o[0], o[1]); w.y = cvt_pk_bf16(o[2], o[3]); w.z = cvt_pk_bf16(o[4], o[5]); w.w = cvt_pk_bf16(o[6], o[7]); return w;
}

__device__ __forceinline__ void p2_ret_item(const Args& A, LAS unsigned char* lds, int b, int n, int h, int tid, int wave, int lane) {
    const bf16_t* Kg = (const bf16_t*)(A.ws + WS_K); const bf16_t* Vg = (const bf16_t*)(A.ws + WS_V); bf16_t* SR = (bf16_t*)((unsigned char*)A.out + OUT_SR);
    LAS unsigned char* vs = lds; LAS unsigned char* ks = lds + T264;
    const int row0 = b * SEQ + n * 128; const float lg = ret_log2_gamma(h);
    for (int i = tid; i < 4096; i += 512) {
        const int r = i >> 5, c = i & 31; const size_t go = (size_t)(row0 + r) * 1024 + h * 256 + c * 8;
        const u32x4 kk = *(const u32x4*)(Kg + go); *(LAS u32x4*)(ks + r * P264 + c * 16) = kk;
        const u32x4 vv = *(const u32x4*)(Vg + go); const float sc = exp2f((float)(127 - r) * lg);
        u32x4 w; w.x = cvt_pk_bf16(bflo(vv.x) * sc, bfhi(vv.x) * sc); w.y = cvt_pk_bf16(bflo(vv.y) * sc, bfhi(vv.y) * sc);
        w.z = cvt_pk_bf16(bflo(vv.z) * sc, bfhi(vv.z) * sc); w.w = cvt_pk_bf16(bflo(vv.w) * sc, bfhi(vv.w) * sc);
        *(LAS u32x4*)(vs + r * P264 + c * 16) = w;
    }
    __syncthreads();
    const int eq = wave >> 1, dh = wave & 1;
    bf16_t* So = SR + (size_t)((b * 16 + n) * 4 + h) * 65536;
#pragma unroll 1
    for (int dq = 0; dq < 2; ++dq) {
        const int d0 = dh * 128 + dq * 64;
        f32x4 acc[4][4];
#pragma unroll
        for (int i = 0; i < 4; ++i)
#pragma unroll
            for (int j = 0; j < 4; ++j) acc[i][j] = (f32x4){0.f, 0.f, 0.f, 0.f};
#pragma unroll
        for (int kt = 0; kt < 4; ++kt) {
            bf16x8 a[4], bb[4];
#pragma unroll
            for (int i = 0; i < 4; ++i) { a[i] = frag_tr(vs, P264, kt * 32, eq * 64 + i * 16, lane); bb[i] = frag_tr(ks, P264, kt * 32, d0 + i * 16, lane); }
#pragma unroll
            for (int i = 0; i < 4; ++i)
#pragma unroll
                for (int j = 0; j < 4; ++j) acc[i][j] = mfma16(a[i], bb[j], acc[i][j]);
        }
#pragma unroll
        for (int i = 0; i < 4; ++i)
#pragma unroll
            for (int j = 0; j < 4; ++j)
#pragma unroll
                for (int jj = 0; jj < 4; ++jj) {
                    const int e = eq * 64 + i * 16 + 4 * (lane >> 4) + jj, d = d0 + j * 16 + (lane & 15);
                    So[e * 256 + d] = f2bf(acc[i][j][jj]);
                }
    }
    __syncthreads();
}

__device__ __forceinline__ void p2_ssd_item(const Args& A, LAS unsigned char* lds, int b, int n, int hq, int tid, int wave, int lane) {
    const bf16_t* XBC = (const bf16_t*)(A.ws + WS_XBC); bf16_t* XC = (bf16_t*)(A.ws + WS_XC); bf16_t* SS = (bf16_t*)((unsigned char*)A.out + OUT_SS);
    const float* DT = (const float*)(A.ws + WS_DT); float* ACS = (float*)(A.ws + WS_ACS);
    LAS unsigned char* xsw = lds; LAS unsigned char* Bs = lds + T264;
    LAS float* dts = (LAS float*)(lds + T264 + T136); LAS float* acl = dts + 512; LAS float* wl = acl + 512;
    const int g = hq >> 1, row0 = b * SEQ + n * 128;
    { const int r = tid >> 2, e = tid & 3; dts[tid] = DT[(size_t)(row0 + r) * 16 + hq * 4 + e]; }
    __syncthreads();
    if (tid < 4) { const float a = -__expf(A.a_log[hq * 4 + tid]); float s = 0.f;
        for (int r = 0; r < 128; ++r) { s += dts[r * 4 + tid] * a; acl[r * 4 + tid] = s; } }
    __syncthreads();
    { const int r = tid >> 2, e = tid & 3; const float ac = acl[tid], tot = acl[127 * 4 + e];
      wl[tid] = dts[tid] * __expf(tot - ac); ACS[(size_t)(row0 + r) * 16 + hq * 4 + e] = ac; }
    __syncthreads();
    for (int i = tid; i < 4096; i += 512) {
        const int r = i >> 5, c = i & 31, col = hq * 256 + c * 8; float o[8];
        conv_silu8(XBC, A.conv_w, A.conv_b, b, n * 128 + r, col, o);
        *(u32x4*)(XC + (size_t)(row0 + r) * CONVD + col) = pack8(o);
        const float w = wl[r * 4 + (c >> 3)];
#pragma unroll
        for (int j = 0; j < 8; ++j) o[j] *= w;
        *(LAS u32x4*)(xsw + r * P264 + c * 16) = pack8(o);
    }
    for (int i = tid; i < 2048; i += 512) {
        const int r = i >> 4, c = i & 15, col = 1024 + g * 128 + c * 8; float o[8];
        conv_silu8(XBC, A.conv_w, A.conv_b, b, n * 128 + r, col, o);
        const u32x4 w = pack8(o);
        *(LAS u32x4*)(Bs + r * P136 + c * 16) = w;
        if ((hq & 1) == 0) *(u32x4*)(XC + (size_t)(row0 + r) * CONVD + col) = w;
    }
    if ((hq & 1) == 0) {
        for (int i = tid; i < 2048; i += 512) {
            const int r = i >> 4, c = i & 15, col = 1280 + g * 128 + c * 8; float o[8];
            conv_silu8(XBC, A.conv_w, A.conv_b, b, n * 128 + r, col, o);
            *(u32x4*)(XC + (size_t)(row0 + r) * CONVD + col) = pack8(o);
        }
    }
    __syncthreads();
    const int e = wave >> 1, kh = wave & 1;
    f32x4 acc[4][4];
#pragma unroll
    for (int i = 0; i < 4; ++i)
#pragma unroll
        for (int j = 0; j < 4; ++j) acc[i][j] = (f32x4){0.f, 0.f, 0.f, 0.f};
#pragma unroll
    for (int kt = 0; kt < 4; ++kt) {
        bf16x8 a[4], bb[4];
#pragma unroll
        for (int i = 0; i < 4; ++i) { a[i] = frag_tr(xsw, P264, kt * 32, e * 64 + i * 16, lane); bb[i] = frag_tr(Bs, P136, kt * 32, kh * 64 + i * 16, lane); }
#pragma unroll
        for (int i = 0; i < 4; ++i)
#pragma unroll
            for (int j = 0; j < 4; ++j) acc[i][j] = mfma16(a[i], bb[j], acc[i][j]);
    }
    bf16_t* So = SS + (size_t)((b * 16 + n) * 16 + hq * 4 + e) * 8192;
#pragma unroll
    for (int i = 0; i < 4; ++i)
#pragma unroll
        for (int j = 0; j < 4; ++j)
#pragma unroll
            for (int jj = 0; jj < 4; ++jj) {
                const int p = i * 16 + 4 * (lane >> 4) + jj, k = kh * 64 + j * 16 + (lane & 15);
                So[p * 128 + k] = f2bf(acc[i][j][jj]);
            }
    __syncthreads();
}

__device__ __forceinline__ void p3_scan(const Args& A, int gtid, int gthreads) {
    bf16_t* SR = (bf16_t*)((unsigned char*)A.out + OUT_SR); bf16_t* SS = (bf16_t*)((unsigned char*)A.out + OUT_SS); const float* ACS = (const float*)(A.ws + WS_ACS);
    for (int it = gtid; it < 131072 + 65536; it += gthreads) {
        bf16_t* base; size_t nstride; float dec[16];
        if (it < 131072) {
            const int bh = it >> 13, off = (it & 8191) * 8, b = bh >> 2, h = bh & 3;
            base = SR + (size_t)(b * 16 * 4 + h) * 65536 + off; nstride = (size_t)4 * 65536;
            const float gd = exp2f(128.f * ret_log2_gamma(h));
#pragma unroll
            for (int n = 0; n < 16; ++n) dec[n] = gd;
        } else {
            const int i2 = it - 131072, bh = i2 >> 10, off = (i2 & 1023) * 8, b = bh >> 4, h = bh & 15;
            base = SS + (size_t)(b * 16 * 16 + h) * 8192 + off; nstride = (size_t)16 * 8192;
#pragma unroll
            for (int n = 0; n < 16; ++n) dec[n] = __expf(ACS[(size_t)(b * SEQ + n * 128 + 127) * 16 + h]);
        }
        u32x4 kv[16];
#pragma unroll
        for (int n = 0; n < 16; ++n) kv[n] = *(const u32x4*)(base + n * nstride);
        float S[8];
#pragma unroll
        for (int j = 0; j < 8; ++j) S[j] = 0.f;
#pragma unroll
        for (int n = 0; n < 16; ++n) {
            *(u32x4*)(base + n * nstride) = pack8(S);
            const float d = dec[n];
            S[0] = d * S[0] + bflo(kv[n].x); S[1] = d * S[1] + bfhi(kv[n].x); S[2] = d * S[2] + bflo(kv[n].y); S[3] = d * S[3] + bfhi(kv[n].y);
            S[4] = d * S[4] + bflo(kv[n].z); S[5] = d * S[5] + bfhi(kv[n].z); S[6] = d * S[6] + bflo(kv[n].w); S[7] = d * S[7] + bfhi(kv[n].w);
        }
    }
}

__device__ __forceinline__ u32x4 mul_bf16x8(u32x4 a, u32x4 g) {
    u32x4 w; w.x = cvt_pk_bf16(bflo(a.x) * bflo(g.x), bfhi(a.x) * bfhi(g.x)); w.y = cvt_pk_bf16(bflo(a.y) * bflo(g.y), bfhi(a.y) * bfhi(g.y));
    w.z = cvt_pk_bf16(bflo(a.z) * bflo(g.z), bfhi(a.z) * bfhi(g.z)); w.w = cvt_pk_bf16(bflo(a.w) * bflo(g.w), bfhi(a.w) * bfhi(g.w)); return w;
}
__device__ __forceinline__ void p4_ret_item(const Args& A, LAS unsigned char* lds, int b, int n, int h, int tid, int wave, int lane) {
    const bf16_t* Qg = (const bf16_t*)(A.ws + WS_Q); const bf16_t* Kg = (const bf16_t*)(A.ws + WS_K); const bf16_t* Vg = (const bf16_t*)(A.ws + WS_V);
    const bf16_t* Gg = (const bf16_t*)(A.ws + WS_G); const bf16_t* SR = (const bf16_t*)((unsigned char*)A.out + OUT_SR); bf16_t* MIX = (bf16_t*)(A.ws + WS_HBUF);
    LAS unsigned char* RA = lds; LAS unsigned char* Ps = lds + T264; LAS unsigned char* RB = lds + T264 + T136;
    constexpr int PC = 144;
    const int row0 = b * SEQ + n * 128; const float lg = ret_log2_gamma(h);
    const int fq = lane >> 4, fr = lane & 15;
    const bf16_t* Sp = SR + (size_t)((b * 16 + n) * 4 + h) * 65536;
#define STAGE_ST(dst, dc) do { for (int i_ = tid; i_ < 2048; i_ += 512) { const int e_ = i_ >> 3, c_ = i_ & 7; \
        *(LAS u32x4*)((dst) + e_ * PC + c_ * 16) = *(const u32x4*)(Sp + e_ * 256 + (dc) * 64 + c_ * 8); } } while (0)
    STAGE_ST(RB, 0);
    bf16x8 qf[8];
#pragma unroll
    for (int kt = 0; kt < 8; ++kt) qf[kt] = gfrag_row(Qg + h * 256, 1024, row0 + 16 * wave, kt * 32, lane);
    f32x4 y[16];
#pragma unroll
    for (int eb = 0; eb < 16; ++eb) y[eb] = (f32x4){0.f, 0.f, 0.f, 0.f};
    __syncthreads();
#pragma unroll
    for (int dc = 0; dc < 4; ++dc) {
        LAS unsigned char* cur = (dc & 1) ? RA : RB; LAS unsigned char* nxt = (dc & 1) ? RB : RA;
        if (dc < 3) STAGE_ST(nxt, dc + 1);
#pragma unroll
        for (int ktl = 0; ktl < 2; ++ktl)
#pragma unroll
            for (int eb = 0; eb < 16; ++eb) y[eb] = mfma16(qf[dc * 2 + ktl], frag_row(cur, PC, eb * 16, ktl * 32, lane), y[eb]);
        __syncthreads();
    }
#undef STAGE_ST
#pragma unroll
    for (int jj = 0; jj < 4; ++jj) { const float qd = exp2f((float)(16 * wave + 4 * fq + jj + 1) * lg);
#pragma unroll
        for (int eb = 0; eb < 16; ++eb) y[eb][jj] *= qd; }
    for (int i = tid; i < 4096; i += 512) { const int r = i >> 5, c = i & 31;
        *(LAS u32x4*)(RA + r * P264 + c * 16) = *(const u32x4*)(Kg + (size_t)(row0 + r) * 1024 + h * 256 + c * 8); }
    __syncthreads();
#pragma unroll
    for (int ch = 0; ch < 2; ++ch) {
        f32x4 sc[4];
#pragma unroll
        for (int ci = 0; ci < 4; ++ci) {
            sc[ci] = (f32x4){0.f, 0.f, 0.f, 0.f};
#pragma unroll
            for (int kt = 0; kt < 8; ++kt) sc[ci] = mfma16(qf[kt], frag_row(RA, P264, (ch * 4 + ci) * 16, kt * 32, lane), sc[ci]);
        }
#pragma unroll
        for (int ci = 0; ci < 4; ++ci)
#pragma unroll
            for (int jj = 0; jj < 4; ++jj) {
                const int c = 16 * wave + 4 * fq + jj, m2 = (ch * 4 + ci) * 16 + fr;
                const float val = (m2 <= c) ? sc[ci][jj] * exp2f((float)(c - m2) * lg) : 0.f;
                *(LAS unsigned short*)(Ps + c * P136 + m2 * 2) = f2bf(val);
            }
        __builtin_amdgcn_sched_barrier(0);
    }
    __syncthreads();
    for (int i = tid; i < 4096; i += 512) { const int r = i >> 5, c = i & 31;
        *(LAS u32x4*)(RA + r * P264 + c * 16) = *(const u32x4*)(Vg + (size_t)(row0 + r) * 1024 + h * 256 + c * 8); }
    __syncthreads();
#pragma unroll
    for (int kt = 0; kt < 4; ++kt) {
        const bf16x8 a = frag_row(Ps, P136, 16 * wave, kt * 32, lane);
#pragma unroll
        for (int eb = 0; eb < 16; ++eb) y[eb] = mfma16(a, frag_tr(RA, P264, kt * 32, eb * 16, lane), y[eb]);
    }
    float rs[4];
#pragma unroll
    for (int jj = 0; jj < 4; ++jj) { float s = 0.f;
#pragma unroll
        for (int eb = 0; eb < 16; ++eb) s += y[eb][jj] * y[eb][jj];
        s += __shfl_xor(s, 1); s += __shfl_xor(s, 2); s += __shfl_xor(s, 4); s += __shfl_xor(s, 8);
        rs[jj] = rsqrtf(s * (1.f / 256.f) + EPS); }
    __syncthreads();
#pragma unroll
    for (int eb = 0; eb < 16; ++eb) {
        const int col = eb * 16 + fr; const float wn = A.ret_norm_w[h * 256 + col];
#pragma unroll
        for (int jj = 0; jj < 4; ++jj)
            *(LAS unsigned short*)(RA + (16 * wave + 4 * fq + jj) * P264 + col * 2) = f2bf(y[eb][jj] * rs[jj] * wn);
    }
    WAVE_LDS_SYNC();
#pragma unroll
    for (int i = 0; i < 8; ++i) {
        const int idx = i * 64 + lane, rr = 16 * wave + (idx >> 5), cc = idx & 31;
        const u32x4 o = *(const LAS u32x4*)(RA + rr * P264 + cc * 16);
        const u32x4 g = *(const u32x4*)(Gg + (size_t)(row0 + rr) * 1024 + h * 256 + cc * 8);
        *(u32x4*)(MIX + (size_t)(row0 + rr) * 2048 + h * 256 + cc * 8) = mul_bf16x8(o, g);
    }
    __syncthreads();
}

__device__ __forceinline__ void p4_ssd_item(const Args& A, LAS unsigned char* lds, int b, int n, int g, int tid_in, int wave, int lane_in) {
    int tid = tid_in, lane = lane_in;
    const bf16_t* XC = (const bf16_t*)(A.ws + WS_XC); const bf16_t* Zg = (const bf16_t*)(A.ws + WS_Z); const bf16_t* SS = (const bf16_t*)((unsigned char*)A.out + OUT_SS);
    const float* DT = (const float*)(A.ws + WS_DT); const float* ACS = (const float*)(A.ws + WS_ACS); bf16_t* MIX = (bf16_t*)(A.ws + WS_HBUF);
    LAS unsigned char* XS = lds; LAS unsigned char* R2 = lds + T264;
    LAS float* acl = (LAS float*)(lds + T264 + T136); LAS float* dtl = acl + 1024;
    constexpr int PP = 264, PSZ = 64 * PP;
    const int row0 = b * SEQ + n * 128; int fq = lane >> 4, fr = lane & 15;
    for (int i = tid; i < 2048; i += 512) { const int r = i >> 4, c = i & 15;
        *(LAS u32x4*)(R2 + r * P136 + c * 16) = *(const u32x4*)(XC + (size_t)(row0 + r) * CONVD + 1024 + g * 128 + c * 8); }
    for (int i = tid; i < 1024; i += 512) { const int r = i >> 3, e = i & 7;
        acl[i] = ACS[(size_t)(row0 + r) * 16 + g * 8 + e]; dtl[i] = DT[(size_t)(row0 + r) * 16 + g * 8 + e]; }
    f32x4 cbm[8];
    {
        bf16x8 cf[4];
#pragma unroll
        for (int kt = 0; kt < 4; ++kt) cf[kt] = gfrag_row(XC + 1280 + g * 128, CONVD, row0 + 16 * wave, kt * 32, lane);
        __syncthreads();
#pragma unroll
        for (int sb = 0; sb < 8; ++sb) {
            cbm[sb] = (f32x4){0.f, 0.f, 0.f, 0.f};
#pragma unroll
            for (int kt = 0; kt < 4; ++kt) cbm[sb] = mfma16(cf[kt], frag_row(R2, P136, sb * 16, kt * 32, lane), cbm[sb]);
        }
    }
    float ssqv[8];
#pragma unroll
    for (int i = 0; i < 8; ++i) ssqv[i] = 0.f;
#pragma unroll 1
    for (int half = 0; half < 2; ++half) {
        asm volatile("" : "+v"(tid), "+v"(lane)); fq = lane >> 4; fr = lane & 15;
        __syncthreads();
        for (int i = tid; i < 4096; i += 512) { const int hp = i >> 4, c = i & 15;
            *(LAS u32x4*)(XS + hp * PP + c * 16) = *(const u32x4*)(SS + (size_t)((b * 16 + n) * 16 + g * 8 + half * 4) * 8192 + (size_t)hp * 128 + c * 8); }
        bf16x8 cf[4];
#pragma unroll
        for (int kt = 0; kt < 4; ++kt) cf[kt] = gfrag_row(XC + 1280 + g * 128, CONVD, row0 + 16 * wave, kt * 32, lane);
        __syncthreads();
        f32x4 acc[4][4];
#pragma unroll
        for (int e4 = 0; e4 < 4; ++e4)
#pragma unroll
            for (int pb = 0; pb < 4; ++pb) acc[e4][pb] = (f32x4){0.f, 0.f, 0.f, 0.f};
#pragma unroll
        for (int e4 = 0; e4 < 4; ++e4)
#pragma unroll
            for (int kt = 0; kt < 4; ++kt) {
#pragma unroll
                for (int pb = 0; pb < 4; ++pb) acc[e4][pb] = mfma16(cf[kt], frag_row(XS + e4 * PSZ, PP, pb * 16, kt * 32, lane), acc[e4][pb]);
                __builtin_amdgcn_sched_barrier(0);
            }
#pragma unroll
        for (int e4 = 0; e4 < 4; ++e4)
#pragma unroll
            for (int jj = 0; jj < 4; ++jj) { const float s = __expf(acl[(16 * wave + 4 * fq + jj) * 8 + half * 4 + e4]);
#pragma unroll
                for (int pb = 0; pb < 4; ++pb) acc[e4][pb][jj] *= s; }
        asm volatile("" : "+v"(tid), "+v"(lane)); fq = lane >> 4; fr = lane & 15;
        __syncthreads();
#pragma unroll 2
        for (int i = tid; i < 4096; i += 512) { const int r = i >> 5, c = i & 31;
            *(LAS u32x4*)(XS + r * P264 + c * 16) = *(const u32x4*)(XC + (size_t)(row0 + r) * CONVD + g * 512 + half * 256 + c * 8); }
        __syncthreads();
#pragma unroll
        for (int e4 = 0; e4 < 4; ++e4) {
            const int e = half * 4 + e4;
            float al[4];
#pragma unroll
            for (int jj = 0; jj < 4; ++jj) al[jj] = acl[(16 * wave + 4 * fq + jj) * 8 + e];
            WAVE_LDS_SYNC();
#pragma unroll
            for (int sb = 0; sb < 8; ++sb) {
                const int s = sb * 16 + fr; const float as = acl[s * 8 + e], ds = dtl[s * 8 + e];
#pragma unroll
                for (int jj = 0; jj < 4; ++jj) { const int l = 16 * wave + 4 * fq + jj;
                    const float val = (s <= l) ? cbm[sb][jj] * __expf(al[jj] - as) * ds : 0.f;
                    *(LAS unsigned short*)(R2 + l * P136 + s * 2) = f2bf(val); }
            }
            WAVE_LDS_SYNC();
#pragma unroll
            for (int kt = 0; kt < 4; ++kt) {
                const bf16x8 a = frag_row(R2, P136, 16 * wave, kt * 32, lane);
#pragma unroll
                for (int pb = 0; pb < 4; ++pb) acc[e4][pb] = mfma16(a, frag_tr(XS, P264, kt * 32, e4 * 64 + pb * 16, lane), acc[e4][pb]);
                __builtin_amdgcn_sched_barrier(0);
            }
            const float dsk = A.d_skip[g * 8 + e];
#pragma unroll
            for (int pb = 0; pb < 4; ++pb)
#pragma unroll
                for (int jj = 0; jj < 4; ++jj)
                    acc[e4][pb][jj] += dsk * bf2f(*(const LAS unsigned short*)(XS + (16 * wave + 4 * fq + jj) * P264 + (e4 * 64 + pb * 16 + fr) * 2));
            __builtin_amdgcn_sched_barrier(0);
        }
        asm volatile("" : "+v"(lane)); fq = lane >> 4; fr = lane & 15;
        __syncthreads();
#pragma unroll
        for (int e4 = 0; e4 < 4; ++e4)
#pragma unroll
            for (int pb = 0; pb < 4; ++pb)
#pragma unroll
                for (int jj = 0; jj < 4; ++jj)
                    *(LAS unsigned short*)(XS + (16 * wave + 4 * fq + jj) * P264 + (e4 * 64 + pb * 16 + fr) * 2) = f2bf(acc[e4][pb][jj]);
        WAVE_LDS_SYNC();
#pragma unroll
        for (int i = 0; i < 8; ++i) {
            const int idx = i * 64 + lane, rr = 16 * wave + (idx >> 5), cc = idx & 31;
            const u32x4 o = *(const LAS u32x4*)(XS + rr * P264 + cc * 16);
            const u32x4 z = *(const u32x4*)(Zg + (size_t)(row0 + rr) * 1024 + g * 512 + half * 256 + cc * 8);
            float v[8];
            v[0] = bflo(o.x) * bflo(z.x); v[1] = bfhi(o.x) * bfhi(z.x); v[2] = bflo(o.y) * bflo(z.y); v[3] = bfhi(o.y) * bfhi(z.y);
            v[4] = bflo(o.z) * bflo(z.z); v[5] = bfhi(o.z) * bfhi(z.z); v[6] = bflo(o.w) * bflo(z.w); v[7] = bfhi(o.w) * bfhi(z.w);
            float ss = (v[0] * v[0] + v[1] * v[1]) + (v[2] * v[2] + v[3] * v[3]) + (v[4] * v[4] + v[5] * v[5]) + (v[6] * v[6] + v[7] * v[7]);
            ss += __shfl_xor(ss, 1); ss += __shfl_xor(ss, 2); ss += __shfl_xor(ss, 4); ss += __shfl_xor(ss, 8); ss += __shfl_xor(ss, 16);
            ssqv[i] += ss;
            *(u32x4*)(MIX + (size_t)(row0 + rr) * 2048 + 1024 + g * 512 + half * 256 + cc * 8) = pack8(v);
            if (i & 1) __builtin_amdgcn_sched_barrier(0);
        }
    }
    asm volatile("s_waitcnt vmcnt(0)" ::: "memory");
#pragma unroll 1
    for (int half = 0; half < 2; ++half)
#pragma unroll
        for (int i = 0; i < 8; ++i) {
            const int idx = i * 64 + lane, rr = 16 * wave + (idx >> 5), cc = idx & 31;
            const float rs = rsqrtf(ssqv[i] * (1.f / 512.f) + EPS);
            bf16_t* p = MIX + (size_t)(row0 + rr) * 2048 + 1024 + g * 512 + half * 256 + cc * 8;
            const u32x4 o = *(const u32x4*)p;
            const f32x4 w0 = *(const f32x4*)(A.ssd_norm_w + g * 512 + half * 256 + cc * 8), w1 = *(const f32x4*)(A.ssd_norm_w + g * 512 + half * 256 + cc * 8 + 4);
            float v[8];
            v[0] = bflo(o.x) * rs * w0[0]; v[1] = bfhi(o.x) * rs * w0[1]; v[2] = bflo(o.y) * rs * w0[2]; v[3] = bfhi(o.y) * rs * w0[3];
            v[4] = bflo(o.z) * rs * w1[0]; v[5] = bfhi(o.z) * rs * w1[1]; v[6] = bflo(o.w) * rs * w1[2]; v[7] = bfhi(o.w) * rs * w1[3];
            *(u32x4*)p = pack8(v);
        }
    __syncthreads();
}

#define XB_TMO      128
#define XB_XCNT(j)  (256  + 64 * (j))
#define XB_XSUB(j)  (1280 + 64 * (j))
#define XB_XGEN(j)  (2304 + 64 * (j))
#define XB_TOP      3328
#define XB_TOPGEN   3392
#define XCD_BAR_WORDS 3456
#define XB_SPIN_CAP (1u << 18)

__device__ __forceinline__ unsigned xb_ld(unsigned* p)              { return __hip_atomic_load(p, __ATOMIC_RELAXED, __HIP_MEMORY_SCOPE_AGENT); }
__device__ __forceinline__ unsigned xb_add(unsigned* p, unsigned v) { return __hip_atomic_fetch_add(p, v, __ATOMIC_RELAXED, __HIP_MEMORY_SCOPE_AGENT); }
__device__ __forceinline__ unsigned xb_xcc_id() { return (unsigned)__builtin_amdgcn_s_getreg((3 << 11) | 20) & 0xFu; }
#define XB_SPIN(cond, bar) do { unsigned _sp = 0; while (cond) { __builtin_amdgcn_s_sleep(1); \
    if ((++_sp & 255u) == 0u) { if (xb_ld(&(bar)[XB_TMO])) break; if (_sp > XB_SPIN_CAP) { atomicAdd(&(bar)[XB_TMO], 1u); break; } } } } while (0)

struct XcdBarrier {
    unsigned* bar; unsigned x;
    volatile LAS unsigned* st;
};

__device__ __forceinline__ XcdBarrier xcd_barrier_post(unsigned* bar, volatile LAS unsigned* st) {
    XcdBarrier b; b.bar = bar; b.x = xb_xcc_id(); b.st = st;
    if (threadIdx.x == 0) (void)xb_add(&bar[XB_XCNT(b.x)], 1u);
    return b;
}
__device__ __forceinline__ void xcd_barrier_complete(unsigned* bar, unsigned x, unsigned& nloc, unsigned& nx) {
    const unsigned G = gridDim.x * gridDim.y * gridDim.z;
    unsigned sum, cnt, mine, sp = 0u;
    for (;;) {
        sum = 0u; cnt = 0u; mine = 0u;
#pragma unroll
        for (unsigned j = 0; j < 16; ++j) { const unsigned c = xb_ld(&bar[XB_XCNT(j)]); sum += c; cnt += (c > 0u) ? 1u : 0u; mine = (j == x) ? c : mine; }
        if (sum == G) break;
        __builtin_amdgcn_s_sleep(1);
        if ((++sp & 255u) == 0u) { if (xb_ld(&bar[XB_TMO])) break; if (sp > XB_SPIN_CAP) { atomicAdd(&bar[XB_TMO], 1u); break; } }
    }
    nloc = mine > 0u ? mine : 1u; nx = cnt > 0u ? cnt : 1u;
}

__device__ __forceinline__ void xcd_barrier(const XcdBarrier& b) {
    asm volatile("s_waitcnt vmcnt(0)" ::: "memory");
    __syncthreads();
    if (threadIdx.x == 0) {
        unsigned* bar = b.bar;
        __builtin_amdgcn_s_waitcnt(0);
        unsigned nloc = b.st[0], nx = b.st[1];
        if (nloc == 0u) { xcd_barrier_complete(bar, b.x, nloc, nx); b.st[0] = nloc; b.st[1] = nx; }
        const unsigned old = xb_add(&bar[XB_XSUB(b.x)], 1u);
        const unsigned gen = old / nloc;
        if (old + 1u == (gen + 1u) * nloc) {
            __builtin_amdgcn_fence(__ATOMIC_RELEASE, "agent");
            asm volatile("s_waitcnt vmcnt(0)" ::: "memory");
            const unsigned og = xb_add(&bar[XB_TOP], 1u);
            const unsigned tg = og / nx;
            if (og + 1u == (tg + 1u) * nx) xb_add(&bar[XB_TOPGEN], 1u);
            else XB_SPIN(xb_ld(&bar[XB_TOPGEN]) == tg, bar);
            __builtin_amdgcn_fence(__ATOMIC_ACQUIRE, "agent");
            xb_add(&bar[XB_XGEN(b.x)], 1u);
            asm volatile("s_waitcnt vmcnt(0)" ::: "memory");
        } else {
            XB_SPIN(xb_ld(&bar[XB_XGEN(b.x)]) == gen, bar);
            __builtin_amdgcn_fence(__ATOMIC_ACQUIRE, "agent");
            asm volatile("s_waitcnt vmcnt(0)" ::: "memory");
        }
    }
    __syncthreads();
}


__global__ void __launch_bounds__(512, 2) hymba_fwd(Args A) {
    extern __shared__ __attribute__((aligned(16))) unsigned char lds_raw[];
    LAS unsigned char* lds = (LAS unsigned char*)lds_raw;
    cg::grid_group grid = cg::this_grid();
    { volatile LAS unsigned* st = (volatile LAS unsigned*)(lds + XB_ST_OFF); if (threadIdx.x < 2) st[threadIdx.x] = 0u; }
    __syncthreads();
    XcdBarrier xbar = xcd_barrier_post((unsigned*)(A.ws + WS_CTL), (volatile LAS unsigned*)(lds + XB_ST_OFF));
    grid.sync();
#define GRID_SYNC() xcd_barrier(xbar)
#define PHASE_IDS() int tid = threadIdx.x; asm volatile("" : "+v"(tid)); const int lane = tid & 63, wave = __builtin_amdgcn_readfirstlane(tid >> 6); const int gw = bx * 8 + wave, ngw = G * 8; (void)gw; (void)ngw; (void)lane
    const int G = gridDim.x, bx = blockIdx.x;
    unsigned char* ws = A.ws;

#ifndef SK0
    for (int rep_ = 0; rep_ < REP0; ++rep_) { PHASE_IDS();
    transpose_weight(A.w_in, DM, INW, (bf16_t*)((unsigned char*)A.out + OUT_WIN), lds, gw, ngw, wave, lane);
    transpose_weight(A.w_out, DM, DM, (bf16_t*)(ws + WS_WOUT), lds, gw, ngw, wave, lane);
    for (int m = gw; m < NT; m += ngw) rms_row_bf16(A.x + (size_t)m * DM, A.norm_mix_w, (bf16_t*)(ws + WS_HBUF) + (size_t)m * DM, lane);
    }
#endif
    GRID_SYNC();

#ifndef SK1
    {
        pg8::Gemm g{(const bf16_t*)(ws + WS_HBUF), (const bf16_t*)((unsigned char*)A.out + OUT_WIN), NT, INW_PAD, DM}; pg8::StaticOrder S; S.init(NT, INW_PAD, G, bx);
        EpiInProj E{(bf16_t*)(ws + WS_Q), (bf16_t*)(ws + WS_XBC), (float*)(ws + WS_DT), A.dt_bias};
        pg8::gemm_phase<EpiInProj, pg8::StaticOrder, true, true>(lds, g, S, E);
    }
    {
        PHASE_IDS();
        const int nwg1 = (NT / 256) * (INW_PAD / 256), full = nwg1 % G, nidle = (full == 0) ? G : G - full;
        const int ib = (full == 0) ? bx : bx - full;
        if (ib >= 0) {
            __syncthreads();
            transpose_weight(A.w_up, DM, DFF, (bf16_t*)(ws + WS_WUP), lds, ib * 8 + wave, nidle * 8, wave, lane);
            transpose_weight(A.w_down, DFF, DM, (bf16_t*)(ws + WS_WDN), lds, ib * 8 + wave, nidle * 8, wave, lane);
        }
    }
#endif
    GRID_SYNC();

#ifndef SK2
    for (int rep_ = 0; rep_ < REP2; ++rep_) { PHASE_IDS();
    for (int it = bx; it < 512; it += G) {
        if (it < 256) p2_ssd_item(A, lds, it >> 6, (it >> 2) & 15, it & 3, tid, wave, lane);
        else { const int j = it - 256; p2_ret_item(A, lds, j >> 6, (j >> 2) & 15, j & 3, tid, wave, lane); }
    }
    }
#endif
    GRID_SYNC();

#ifndef SK3
    { PHASE_IDS(); p3_scan(A, bx * 512 + tid, G * 512); }
#endif
    GRID_SYNC();

#ifndef SK4
    {
        const int half = G >> 1;
        if (bx < half || half == 0) { PHASE_IDS();
            for (int it = bx; it < 128; it += (half ? half : 1)) p4_ssd_item(A, lds, it >> 5, (it >> 1) & 15, it & 1, tid, wave, lane);
        }
        if (bx >= half) { PHASE_IDS();
            for (int j = bx - half; j < 256; j += G - half) p4_ret_item(A, lds, j >> 6, (j >> 2) & 15, j & 3, tid, wave, lane);
        }
    }
#endif
    GRID_SYNC();

#ifndef SK5
    {
        pg8::Gemm g{(const bf16_t*)(ws + WS_HBUF), (const bf16_t*)(ws + WS_WOUT), NT, DM, DM}; pg8::StaticOrder S; S.init(NT, DM, G, bx);
        EpiOutProj E{A.x, A.out, (bf16_t*)(ws + WS_H2W), A.norm_mlp_w, (float*)(ws + WS_SSQ2)};
        pg8::gemm_phase<EpiOutProj, pg8::StaticOrder, true, true>(lds, g, S, E);
    }
#endif
    GRID_SYNC();

#ifndef SK6
    {
        pg8::Gemm g{(const bf16_t*)(ws + WS_H2W), (const bf16_t*)(ws + WS_WUP), NT, DFF, DM}; pg8::StaticOrder S; S.init(NT, DFF, G, bx);
        EpiUp E{(bf16_t*)(ws + WS_U), (const float*)(ws + WS_SSQ2)};
        for (int rep_ = 0; rep_ < REP6; ++rep_) pg8::gemm_phase<EpiUp, pg8::StaticOrder, true, true>(lds, g, S, E);
    }
#endif
    GRID_SYNC();

#ifndef SK7
    {
        pg8::Gemm g{(const bf16_t*)(ws + WS_U), (const bf16_t*)(ws + WS_WDN), NT, DM, DFF}; pg8::StaticOrder S; S.init(NT, DM, G, bx);
        EpiDown E{A.out, (float*)(ws + WS_SSQ3)};
        pg8::gemm_phase<EpiDown, pg8::StaticOrder, true, true>(lds, g, S, E);
    }
#endif
    GRID_SYNC();

    { PHASE_IDS();
    for (int m = gw; m < NT; m += ngw) {
        const float* sp = (const float*)(ws + WS_SSQ3) + (size_t)m * 32;
        const float s = wave_sum(lane < 32 ? sp[lane] : 0.f);
        const float rs = rsqrtf(s * (1.f / DM) + EPS);
        f32x4* o = (f32x4*)(A.out + (size_t)m * DM) + lane; const f32x4* wv = (const f32x4*)A.norm_final_w + lane;
#pragma unroll
        for (int j = 0; j < 8; ++j) { f32x4 v = o[64 * j]; const f32x4 w = wv[64 * j]; v = v * rs * w; o[64 * j] = v; }
    }
    }
}

extern "C" void kernel_launch(void* const* d_in, const int* in_sizes, int n_in, void* d_out, int out_size, void* d_ws, size_t ws_size, hipStream_t stream) {
    static int grid = 0;
    if (grid == 0) {
        int dev = 0, cus = 0, per_cu = 0;
        hipGetDevice(&dev);
        hipDeviceGetAttribute(&cus, hipDeviceAttributeMultiprocessorCount, dev);
        hipFuncSetAttribute((const void*)hymba_fwd, hipFuncAttributeMaxDynamicSharedMemorySize, LDS_BYTES);
        hipOccupancyMaxActiveBlocksPerMultiprocessor(&per_cu, (const void*)hymba_fwd, 512, LDS_BYTES);
        if (per_cu < 1 || cus < 1 || n_in != 15 || ws_size < 256 * MiB) { fprintf(stderr, "kernel_launch: bad configuration (cus %d per_cu %d n_in %d ws %zu)\n", cus, per_cu, n_in, ws_size); grid = -1; }
        else grid = cus * per_cu;
    }
    if (grid < 0) return;
    Args a{};
    a.x = (const float*)d_in[0]; a.norm_mix_w = (const float*)d_in[1]; a.w_in = (const float*)d_in[2]; a.ret_norm_w = (const float*)d_in[3];
    a.conv_w = (const float*)d_in[4]; a.conv_b = (const float*)d_in[5]; a.dt_bias = (const float*)d_in[6]; a.a_log = (const float*)d_in[7];
    a.d_skip = (const float*)d_in[8]; a.ssd_norm_w = (const float*)d_in[9]; a.w_out = (const float*)d_in[10]; a.norm_mlp_w = (const float*)d_in[11];
    a.w_up = (const float*)d_in[12]; a.w_down = (const float*)d_in[13]; a.norm_final_w = (const float*)d_in[14];
    a.out = (float*)d_out; a.ws = (unsigned char*)d_ws;
    if (hipMemsetAsync((char*)d_ws + WS_CTL, 0, 16384, stream) != hipSuccess) { fprintf(stderr, "memset failed\n"); return; }
    void* args[] = {&a};
    hipError_t e = hipLaunchCooperativeKernel((const void*)hymba_fwd, dim3(grid), dim3(512), args, LDS_BYTES, stream);
    if (e != hipSuccess) fprintf(stderr, "cooperative launch failed: %s (grid %d)\n", hipGetErrorString(e), grid);
}
```
